# Optimizing an MI355X kernel written in HIP

```python
import jax, jax.numpy as jnp
from jax import lax
import numpy as np

D_MODEL = 1024
BATCH = 2
SEQ = 8192
DEPTH = 1

MEM_LEN = 256
RET_HEADS = 4
RET_QK_DIM = 64
RET_V_DIM = 128
RET_WIDTH = RET_HEADS * RET_V_DIM
RET_CHUNK = 128
ROPE_BASE = 10000.0
DIL_HEADS = 8
DIL_HEAD_DIM = 64
DIL_WIDTH = DIL_HEADS * DIL_HEAD_DIM
DIL_CONFIGS = ((128, 1), (512, 4), (2048, 16))
DIL_BLOCK = 128
MIX_WIDTH = RET_WIDTH + DIL_WIDTH
XATTN_HEADS = 4
XATTN_HEAD_DIM = D_MODEL // XATTN_HEADS
N_GROUPS = 4
EXPERTS_PER_GROUP = 8
N_EXPERTS = N_GROUPS * EXPERTS_PER_GROUP
TOP_K_INNER = 2
EXPERT_FF = 512
MOE_BLOCK = 128
LN_EPS = 1e-5
GN_EPS = 1e-6
ALPHA = (2.0 * DEPTH) ** 0.25
BETA = (8.0 * DEPTH) ** -0.25

kernel_name = 'hybrid_retention_dilated_hmoe_layer'


def layer_norm(x, g, b):
    xf = x.astype(jnp.float32)
    mu = jnp.mean(xf, axis=-1, keepdims=True)
    var = jnp.mean(jnp.square(xf - mu), axis=-1, keepdims=True)
    y = (xf - mu) * lax.rsqrt(var + LN_EPS) * g.astype(jnp.float32) + b.astype(jnp.float32)
    return y.astype(x.dtype)


def rotary(t, pos):
    half = t.shape[-1] // 2
    inv = 1.0 / (ROPE_BASE ** (jnp.arange(half, dtype=jnp.float32) / half))
    ang = pos.astype(jnp.float32)[:, None] * inv[None, :]
    cos = jnp.cos(ang)[None, :, None, :]
    sin = jnp.sin(ang)[None, :, None, :]
    tf = t.astype(jnp.float32)
    t1, t2 = tf[..., :half], tf[..., half:]
    return jnp.concatenate([t1 * cos - t2 * sin, t1 * sin + t2 * cos], axis=-1)


def chunkwise_retention(q, k, v):
    B, S, H, dk = q.shape
    dv = v.shape[-1]
    C = RET_CHUNK
    N = S // C
    pos = jnp.arange(S)
    q = rotary(q, pos)
    k = rotary(k, pos) * (dk ** -0.5)

    def chunks(t):
        return t.astype(jnp.float32).reshape(B, N, C, H, t.shape[-1]).transpose(0, 3, 1, 2, 4)

    qc, kc, vc = chunks(q), chunks(k), chunks(v)
    lg = jnp.log(1.0 - jnp.exp2(-5.0 - jnp.arange(H, dtype=jnp.float32)))
    idx = jnp.arange(C, dtype=jnp.float32)
    diff = idx[:, None] - idx[None, :]
    decay = jnp.where(diff >= 0, jnp.exp(lg[:, None, None] * jnp.maximum(diff, 0.0)), 0.0)
    scores = jnp.einsum('bhnid,bhnjd->bhnij', qc, kc) * decay[None, :, None]
    y_intra = jnp.einsum('bhnij,bhnje->bhnie', scores, vc)
    zeta = jnp.exp(lg[:, None] * (C - 1.0 - idx))[None, :, None, :, None]
    kv = jnp.einsum('bhnjd,bhnje->nbhde', kc * zeta, vc)
    g_chunk = jnp.exp(lg * C)[None, :, None, None]

    def step(state, kv_n):
        return g_chunk * state + kv_n, state

    _, state_prev = lax.scan(step, jnp.zeros((B, H, dk, dv), jnp.float32), kv)
    xi = jnp.exp(lg[:, None] * (idx + 1.0))[None, :, None, :, None]
    y_cross = jnp.einsum('bhnid,nbhde->bhnie', qc, state_prev) * xi
    y = y_intra + y_cross
    mu = jnp.mean(y, axis=-1, keepdims=True)
    var = jnp.mean(jnp.square(y - mu), axis=-1, keepdims=True)
    y = (y - mu) * lax.rsqrt(var + GN_EPS)
    return y.transpose(0, 2, 3, 1, 4).reshape(B, S, H * dv)


def dilated_branch(q, k, v, window, dilation):
    B, S, H, dh = q.shape
    L = S // dilation
    Q = DIL_BLOCK
    nb = -(-L // Q)
    Lp = nb * Q
    w_sub = window // dilation

    def sub(t):
        t = t.reshape(B, L, dilation, H, dh).transpose(0, 2, 3, 1, 4)
        t = jnp.pad(t, ((0, 0), (0, 0), (0, 0), (0, Lp - L), (0, 0)))
        return t.reshape(B, dilation, H, nb, Q, dh)

    def with_prev(t):
        prev = jnp.pad(t[:, :, :, :-1], ((0, 0), (0, 0), (0, 0), (1, 0), (0, 0), (0, 0)))
        return jnp.concatenate([prev, t], axis=-2)

    qb = sub(q)
    kk = with_prev(sub(k))
    vv = with_prev(sub(v))
    s = jnp.einsum('brhnid,brhnjd->brhnij', qb, kk).astype(jnp.float32) * (dh ** -0.5)
    i = jnp.arange(Q)[:, None]
    j = jnp.arange(2 * Q)[None, :]
    dist = i + Q - j
    blk = jnp.arange(nb)[:, None, None]
    valid = (dist >= 0) & (dist <= w_sub) & ((blk > 0) | (j >= Q))
    s = jnp.where(valid, s, -jnp.inf)
    m = jnp.max(s, axis=-1, keepdims=True)
    p = jnp.exp(s - m)
    den = jnp.sum(p, axis=-1, keepdims=True)
    o = jnp.einsum('brhnij,brhnjd->brhnid', p, vv.astype(jnp.float32)) / den
    lse = (m + jnp.log(den))[..., 0]
    o = o.reshape(B, dilation, H, Lp, dh)[:, :, :, :L].transpose(0, 3, 1, 2, 4).reshape(B, S, H, dh)
    lse = lse.reshape(B, dilation, H, Lp)[:, :, :, :L].transpose(0, 3, 1, 2).reshape(B, S, H)
    return o, lse


def dilated_attention(q, k, v):
    outs = []
    lses = []
    for window, dilation in DIL_CONFIGS:
        o, lse = dilated_branch(q, k, v, window, dilation)
        outs.append(o)
        lses.append(lse)
    wts = jax.nn.softmax(jnp.stack(lses, axis=0), axis=0)
    o = jnp.sum(wts[..., None] * jnp.stack(outs, axis=0), axis=0)
    B, S, H, dh = o.shape
    return o.reshape(B, S, H * dh)


def hybrid_mixer(x, w_in, w_out):
    B, S, _ = x.shape
    rq = RET_HEADS * RET_QK_DIM
    h = x @ w_in
    cuts = [rq, 2 * rq, 2 * rq + RET_WIDTH, 2 * rq + 2 * RET_WIDTH,
            2 * rq + 2 * RET_WIDTH + DIL_WIDTH, 2 * rq + 2 * RET_WIDTH + 2 * DIL_WIDTH]
    r_q, r_k, r_v, r_g, d_q, d_k, d_v = jnp.split(h, cuts, axis=-1)
    y_ret = chunkwise_retention(r_q.reshape(B, S, RET_HEADS, RET_QK_DIM),
                                r_k.reshape(B, S, RET_HEADS, RET_QK_DIM),
                                r_v.reshape(B, S, RET_HEADS, RET_V_DIM))
    y_ret = jax.nn.silu(r_g.astype(jnp.float32)) * y_ret
    y_dil = dilated_attention(d_q.reshape(B, S, DIL_HEADS, DIL_HEAD_DIM),
                              d_k.reshape(B, S, DIL_HEADS, DIL_HEAD_DIM),
                              d_v.reshape(B, S, DIL_HEADS, DIL_HEAD_DIM))
    y = jnp.concatenate([y_ret, y_dil], axis=-1).astype(x.dtype)
    return y @ w_out


def memory_cross_attention(x, mem, w_q, w_kv, w_o):
    B, S, D = x.shape
    M = mem.shape[1]
    q = (x @ w_q).reshape(B, S, XATTN_HEADS, XATTN_HEAD_DIM)
    kv = mem @ w_kv
    k = kv[..., :D].reshape(B, M, XATTN_HEADS, XATTN_HEAD_DIM)
    v = kv[..., D:].reshape(B, M, XATTN_HEADS, XATTN_HEAD_DIM)
    s = jnp.einsum('bshd,bmhd->bhsm', q, k).astype(jnp.float32) * (XATTN_HEAD_DIM ** -0.5)
    p = jax.nn.softmax(s, axis=-1)
    o = jnp.einsum('bhsm,bmhd->bshd', p, v.astype(jnp.float32)).reshape(B, S, D).astype(x.dtype)
    return o @ w_o


def hierarchical_moe(x, w_rg, w_re, w_g, w_u, w_d):
    B, S, D = x.shape
    T = B * S
    A = T * TOP_K_INNER
    xt = x.reshape(T, D)
    p_group = jax.nn.softmax((xt @ w_rg).astype(jnp.float32), axis=-1)
    g1, gi = lax.top_k(p_group, 1)
    lg_exp = (xt @ w_re).astype(jnp.float32).reshape(T, N_GROUPS, EXPERTS_PER_GROUP)
    lg_sel = jnp.take_along_axis(lg_exp, gi[:, :, None], axis=1)[:, 0]
    v2, li = lax.top_k(lg_sel, TOP_K_INNER)
    g2 = jax.nn.softmax(v2, axis=-1)
    gates = (g1 * g2).reshape(-1)
    eid = (gi * EXPERTS_PER_GROUP + li).reshape(-1)
    tok = jnp.repeat(jnp.arange(T, dtype=jnp.int32), TOP_K_INNER)
    order = jnp.argsort(eid)
    e_s, tok_s, g_s = eid[order], tok[order], gates[order]
    counts = jnp.bincount(eid, length=N_EXPERTS)
    padded = ((counts + MOE_BLOCK - 1) // MOE_BLOCK) * MOE_BLOCK
    off = jnp.cumsum(counts) - counts
    pend = jnp.cumsum(padded)
    poff = pend - padded
    dest = poff[e_s] + (jnp.arange(A) - off[e_s])
    R = A + N_EXPERTS * MOE_BLOCK
    nblk = R // MOE_BLOCK
    row_tok = jnp.zeros((R,), jnp.int32).at[dest].set(tok_s)
    row_gate = jnp.zeros((R,), jnp.float32).at[dest].set(g_s)
    blk_exp = jnp.minimum(jnp.searchsorted(pend, jnp.arange(nblk) * MOE_BLOCK, side='right'), N_EXPERTS - 1)
    x_rows = xt[row_tok].reshape(nblk, MOE_BLOCK, D)

    def expert_block(args):
        xb, e = args
        return (jax.nn.silu(xb @ w_g[e]) * (xb @ w_u[e])) @ w_d[e]

    y_rows = lax.map(expert_block, (x_rows, blk_exp)).reshape(R, D)
    out = jnp.zeros((T, D), jnp.float32).at[row_tok].add(y_rows.astype(jnp.float32) * row_gate[:, None])
    return out.astype(x.dtype).reshape(B, S, D)


def setup_inputs(seed: int = 0) -> dict:
    key = jax.random.key(seed)
    ks = jax.random.split(key, 24)
    D = D_MODEL
    sd = D ** -0.5
    rq = RET_HEADS * RET_QK_DIM

    def nrm(k, shape, scale):
        return jax.random.normal(k, shape, jnp.float32) * scale

    x = nrm(ks[0], (BATCH, SEQ, D), 1.0)
    mem = nrm(ks[1], (BATCH, MEM_LEN, D), 1.0)
    w_in = jnp.concatenate([
        nrm(ks[2], (DEPTH, D, 2 * rq), sd),
        nrm(ks[3], (DEPTH, D, RET_WIDTH), sd * BETA),
        nrm(ks[4], (DEPTH, D, RET_WIDTH), sd),
        nrm(ks[5], (DEPTH, D, 2 * DIL_WIDTH), sd),
        nrm(ks[6], (DEPTH, D, DIL_WIDTH), sd * BETA),
    ], axis=-1)
    w_out = nrm(ks[7], (DEPTH, MIX_WIDTH, D), (MIX_WIDTH ** -0.5) * BETA)
    ln_mix_g = 1.0 + nrm(ks[8], (DEPTH, D), 0.02)
    ln_mix_b = nrm(ks[9], (DEPTH, D), 0.02)
    w_xq = nrm(ks[10], (DEPTH, D, D), sd)
    w_xkv = jnp.concatenate([nrm(ks[11], (DEPTH, D, D), sd), nrm(ks[12], (DEPTH, D, D), sd * BETA)], axis=-1)
    w_xo = nrm(ks[13], (DEPTH, D, D), sd * BETA)
    ln_x_g = 1.0 + nrm(ks[14], (DEPTH, D), 0.02)
    ln_x_b = nrm(ks[15], (DEPTH, D), 0.02)
    w_route_group = nrm(ks[16], (DEPTH, D, N_GROUPS), sd)
    w_route_expert = nrm(ks[17], (DEPTH, D, N_EXPERTS), sd)
    w_exp_gate = nrm(ks[18], (DEPTH, N_EXPERTS, D, EXPERT_FF), sd * BETA)
    w_exp_up = nrm(ks[19], (DEPTH, N_EXPERTS, D, EXPERT_FF), sd * BETA)
    w_exp_down = nrm(ks[20], (DEPTH, N_EXPERTS, EXPERT_FF, D), (EXPERT_FF ** -0.5) * BETA)
    ln_moe_g = 1.0 + nrm(ks[21], (DEPTH, D), 0.02)
    ln_moe_b = nrm(ks[22], (DEPTH, D), 0.02)
    return {'x': x, 'mem': mem, 'w_in': w_in, 'w_out': w_out, 'ln_mix_g': ln_mix_g, 'ln_mix_b': ln_mix_b,
            'w_xq': w_xq, 'w_xkv': w_xkv, 'w_xo': w_xo, 'ln_x_g': ln_x_g, 'ln_x_b': ln_x_b,
            'w_route_group': w_route_group, 'w_route_expert': w_route_expert,
            'w_exp_gate': w_exp_gate, 'w_exp_up': w_exp_up, 'w_exp_down': w_exp_down,
            'ln_moe_g': ln_moe_g, 'ln_moe_b': ln_moe_b}


def reference(x, mem, w_in, w_out, ln_mix_g, ln_mix_b, w_xq, w_xkv, w_xo, ln_x_g, ln_x_b,
              w_route_group, w_route_expert, w_exp_gate, w_exp_up, w_exp_down, ln_moe_g, ln_moe_b):
    for l in range(DEPTH):
        x = layer_norm(ALPHA * x + hybrid_mixer(x, w_in[l], w_out[l]), ln_mix_g[l], ln_mix_b[l])
        x = layer_norm(ALPHA * x + memory_cross_attention(x, mem, w_xq[l], w_xkv[l], w_xo[l]),
                       ln_x_g[l], ln_x_b[l])
        x = layer_norm(ALPHA * x + hierarchical_moe(x, w_route_group[l], w_route_expert[l],
                                                    w_exp_gate[l], w_exp_up[l], w_exp_down[l]),
                       ln_moe_g[l], ln_moe_b[l])
    return x
```

```cpp
#include <hip/hip_runtime.h>
#include <hip/hip_cooperative_groups.h>
#include <cstdio>
#include <cstdint>
namespace cg = cooperative_groups;

typedef unsigned short bf16_t;
typedef float f32x4 __attribute__((ext_vector_type(4)));
typedef unsigned u32x4 __attribute__((ext_vector_type(4)));

constexpr int T_ = 16384, D_ = 1024, S_ = 8192;
constexpr float ALPHA = 1.189207115002721f;
constexpr float LN_EPS = 1e-5f, GN_EPS = 1e-6f;
constexpr int NEXP = 32, RROWS = 32768 + 32 * 128;

constexpr size_t MiB = 1u << 20;
constexpr size_t OFF_WIN = 0, OFF_WOUT = 6 * MiB, OFF_WXQ = 8 * MiB, OFF_WXKV = 10 * MiB, OFF_WXO = 14 * MiB, OFF_WGU = 16 * MiB, OFF_WD = 80 * MiB;
constexpr size_t OFF_RB = 112 * MiB;
constexpr size_t OFF_KV = 144 * MiB;
constexpr size_t OFF_KVB = 160 * MiB;
constexpr size_t OFF_MEMB = 162 * MiB;
constexpr size_t OFF_ROPE = 163 * MiB;
constexpr size_t OFF_LSE = 165 * MiB;
constexpr size_t OFF_MISC = 167 * MiB;
constexpr size_t OFF_CNT = OFF_MISC;
constexpr size_t OFF_EID = OFF_MISC + 4096;
constexpr size_t OFF_GATE = OFF_EID + 131072;
constexpr size_t OFF_RANK = OFF_GATE + 131072;
constexpr size_t OFF_DEST = OFF_RANK + 131072;
constexpr size_t OFF_RTOK = OFF_DEST + 131072;
constexpr size_t OFF_RA = 168 * MiB;
constexpr size_t OFF_HB = OFF_RA;
constexpr size_t OFF_V1 = OFF_RA, OFF_X1B = OFF_RA + 64 * MiB;
constexpr size_t OFF_OB = OFF_RA, OFF_V2 = OFF_RA + 32 * MiB;
constexpr size_t OFF_HEXP = OFF_RA, OFF_YEXP = OFF_RA + 36 * MiB;

struct Params {
    const float *x, *mem, *w_in, *w_out, *ln_mix_g, *ln_mix_b, *w_xq, *w_xkv, *w_xo, *ln_x_g, *ln_x_b, *w_rg, *w_re, *w_eg, *w_eu, *w_ed, *ln_moe_g, *ln_moe_b;
    float* out;
    unsigned char* ws;
};

__device__ __forceinline__ float bf2f(bf16_t v) { return __uint_as_float(((unsigned)v) << 16); }
__device__ __forceinline__ float bf_lo(unsigned v) { return __uint_as_float(v << 16); }
__device__ __forceinline__ float bf_hi(unsigned v) { return __uint_as_float(v & 0xffff0000u); }
__device__ __forceinline__ unsigned f2bf(float f) { unsigned u = __float_as_uint(f); u += 0x7fffu + ((u >> 16) & 1u); return u >> 16; }
__device__ __forceinline__ unsigned pack2(float a, float b) { return f2bf(a) | (f2bf(b) << 16); }
__device__ __forceinline__ float wave_sum(float v) {
#pragma unroll
    for (int o = 32; o > 0; o >>= 1) v += __shfl_xor(v, o);
    return v;
}
__device__ __forceinline__ float wave_max(float v) {
#pragma unroll
    for (int o = 32; o > 0; o >>= 1) v = fmaxf(v, __shfl_xor(v, o));
    return v;
}
__device__ __forceinline__ float silu(float v) { return v / (1.0f + __expf(-v)); }

__device__ void transpose_tiles(const float* __restrict__ src, int K, int N, int nmat, bf16_t* __restrict__ dst, size_t dst_mat_stride, int mode, float* sm, const float* __restrict__ kscale = nullptr, int vb = -1, int nvb = 0) {
    if (vb < 0) { vb = blockIdx.x; nvb = gridDim.x; }
    float (*tile)[65] = (float (*)[65])sm;
    const int tk = K / 64, tn = N / 64, per = tk * tn, total = per * nmat, tid = threadIdx.x;
    for (int it = vb; it < total; it += nvb) {
        const int m = it / per, r = it % per, k0 = (r / tn) * 64, n0 = (r % tn) * 64;
        const float* s = src + (size_t)m * K * N;
        bf16_t* d = dst + (size_t)m * dst_mat_stride;
        __syncthreads();
#pragma unroll
        for (int i = 0; i < 4; ++i) {
            const int item = tid + 256 * i, k = item >> 4, n4 = (item & 15) * 4;
            const float4 v = *(const float4*)(s + (size_t)(k0 + k) * N + n0 + n4); const float sc = kscale ? kscale[k0 + k] : 1.0f;
            tile[k][n4] = v.x * sc; tile[k][n4 + 1] = v.y * sc; tile[k][n4 + 2] = v.z * sc; tile[k][n4 + 3] = v.w * sc;
        }
        __syncthreads();
#pragma unroll
        for (int i = 0; i < 2; ++i) {
            const int item = tid + 256 * i, kc = item & 7, n = item >> 3; int nn = n0 + n;
            if (mode == 1) nn = (nn >> 4) * 32 + (nn & 15); else if (mode == 2) nn = (nn >> 4) * 32 + 16 + (nn & 15);
            uint4 o;
            o.x = pack2(tile[kc * 8 + 0][n], tile[kc * 8 + 1][n]); o.y = pack2(tile[kc * 8 + 2][n], tile[kc * 8 + 3][n]);
            o.z = pack2(tile[kc * 8 + 4][n], tile[kc * 8 + 5][n]); o.w = pack2(tile[kc * 8 + 6][n], tile[kc * 8 + 7][n]);
            *(uint4*)(d + (size_t)nn * K + k0 + kc * 8) = o;
        }
    }
}


__device__ __forceinline__ void expert_transpose_tile(const Params& p, int q, float* sm) {
    float (*tile)[65] = (float (*)[65])sm;
    const int which = q >> 12, idx = q & 4095, m = idx >> 7, r = idx & 127, tid = threadIdx.x;
    const int K = which == 2 ? 512 : 1024, N = which == 2 ? 1024 : 512, tn = N / 64;
    const int k0 = (r / tn) * 64, n0 = (r % tn) * 64;
    const float* s = (which == 0 ? p.w_eg : (which == 1 ? p.w_eu : p.w_ed)) + (size_t)m * K * N;
    bf16_t* d = which == 2 ? (bf16_t*)(p.ws + OFF_WD) + (size_t)m * 1024 * 512 : (bf16_t*)(p.ws + OFF_WGU) + (size_t)m * 1024 * 1024;
    __syncthreads();
#pragma unroll
    for (int i = 0; i < 4; ++i) {
        const int item = tid + 256 * i, k = item >> 4, n4 = (item & 15) * 4;
        const f32x4 v = __builtin_nontemporal_load((const f32x4*)(s + (size_t)(k0 + k) * N + n0 + n4));
        tile[k][n4] = v[0]; tile[k][n4 + 1] = v[1]; tile[k][n4 + 2] = v[2]; tile[k][n4 + 3] = v[3];
    }
    __syncthreads();
#pragma unroll
    for (int i = 0; i < 2; ++i) {
        const int item = tid + 256 * i, kc = item & 7, n = item >> 3; int nn = n0 + n;
        if (which == 0) nn = (nn >> 5) * 64 + (nn & 31); else if (which == 1) nn = (nn >> 5) * 64 + 32 + (nn & 31);
        uint4 o;
        o.x = pack2(tile[kc * 8 + 0][n], tile[kc * 8 + 1][n]); o.y = pack2(tile[kc * 8 + 2][n], tile[kc * 8 + 3][n]);
        o.z = pack2(tile[kc * 8 + 4][n], tile[kc * 8 + 5][n]); o.w = pack2(tile[kc * 8 + 6][n], tile[kc * 8 + 7][n]);
        __builtin_nontemporal_store((u32x4){o.x, o.y, o.z, o.w}, (u32x4*)(d + (size_t)nn * K + k0 + kc * 8));
    }
}

__device__ void phase0(const Params& p, float* sm) {
    const int tid = threadIdx.x, nth = gridDim.x * 256, gtid = blockIdx.x * 256 + tid;
    {
        const float4* src = (const float4*)p.x; uint2* dst = (uint2*)(p.ws + OFF_RB);
        for (int i = gtid; i < T_ * D_ / 4; i += 4 * nth) {
            float4 v[4];
#pragma unroll
            for (int u = 0; u < 4; ++u) { const int j = i + u * nth; v[u] = j < T_ * D_ / 4 ? src[j] : make_float4(0.f, 0.f, 0.f, 0.f); }
#pragma unroll
            for (int u = 0; u < 4; ++u) { const int j = i + u * nth; if (j < T_ * D_ / 4) { uint2 o; o.x = pack2(v[u].x, v[u].y); o.y = pack2(v[u].z, v[u].w); dst[j] = o; } }
        }
        const float4* src2 = (const float4*)p.mem; uint2* dst2 = (uint2*)(p.ws + OFF_MEMB);
        for (int i = gtid; i < 512 * D_ / 4; i += nth) { const float4 v = src2[i]; uint2 o; o.x = pack2(v.x, v.y); o.y = pack2(v.z, v.w); dst2[i] = o; }
    }
    {
        float2* rope = (float2*)(p.ws + OFF_ROPE);
        for (int i = gtid; i < 8192 * 32; i += nth) {
            const int pos = i >> 5, d = i & 31; double inv = 1.0;
            for (int q = 0; q < d; ++q) inv *= 0.7498942093324558;
            double rev = (double)pos * inv * 0.15915494309189535; rev -= floor(rev);
            const float rf = (float)rev;
            rope[i] = make_float2(__builtin_amdgcn_cosf(rf), __builtin_amdgcn_sinf(rf));
        }
        int* cnt = (int*)(p.ws + OFF_CNT);
        if (gtid < 32) cnt[gtid] = 0;
        int* rtok = (int*)(p.ws + OFF_RTOK);
        for (int i = gtid; i < RROWS; i += nth) rtok[i] = 0;
    }
    transpose_tiles(p.w_in, 1024, 3072, 1, (bf16_t*)(p.ws + OFF_WIN), 0, 0, sm);
    transpose_tiles(p.w_xkv, 1024, 2048, 1, (bf16_t*)(p.ws + OFF_WXKV), 0, 0, sm);
}

template <class Epi>
__device__ __forceinline__ void gemm_tile64(const bf16_t* __restrict__ A, int lda, const int* __restrict__ rowidx, int row0,
                                            const bf16_t* __restrict__ Bt, int ldb, int col0, int K, const Epi& epi, float* sm) {
    float (*As)[68] = (float (*)[68])sm;
    float (*Bs)[68] = (float (*)[68])(sm + 16 * 68);
    const int tid = threadIdx.x, tx = tid & 15, ty = tid >> 4, lr = tid >> 2, lk = (tid & 3) * 4;
    const int arow = rowidx ? rowidx[row0 + lr] : row0 + lr;
    const bf16_t* ap = A + (size_t)arow * lda + lk;
    const bf16_t* bp = Bt + (size_t)(col0 + lr) * ldb + lk;
    float acc[4][4];
#pragma unroll
    for (int i = 0; i < 4; ++i)
#pragma unroll
        for (int j = 0; j < 4; ++j) acc[i][j] = 0.f;
    for (int k0 = 0; k0 < K; k0 += 16) {
        const uint2 av = *(const uint2*)(ap + k0), bv = *(const uint2*)(bp + k0);
        __syncthreads();
        As[lk + 0][lr] = bf_lo(av.x); As[lk + 1][lr] = bf_hi(av.x); As[lk + 2][lr] = bf_lo(av.y); As[lk + 3][lr] = bf_hi(av.y);
        Bs[lk + 0][lr] = bf_lo(bv.x); Bs[lk + 1][lr] = bf_hi(bv.x); Bs[lk + 2][lr] = bf_lo(bv.y); Bs[lk + 3][lr] = bf_hi(bv.y);
        __syncthreads();
#pragma unroll
        for (int k = 0; k < 16; ++k) {
            const float4 a = *(const float4*)&As[k][ty * 4], b = *(const float4*)&Bs[k][tx * 4];
            const float aa[4] = {a.x, a.y, a.z, a.w}, bb[4] = {b.x, b.y, b.z, b.w};
#pragma unroll
            for (int i = 0; i < 4; ++i)
#pragma unroll
                for (int j = 0; j < 4; ++j) acc[i][j] += aa[i] * bb[j];
        }
    }
#pragma unroll
    for (int i = 0; i < 4; ++i) epi(row0 + ty * 4 + i, col0 + tx * 4, (f32x4){acc[i][0], acc[i][1], acc[i][2], acc[i][3]});
}

struct EpiBf16 {
    static constexpr bool PAIRED = false, WHOLE = false, PERM = false;
    bf16_t* O; int ldc;
    __device__ __forceinline__ void operator()(int row, int col, f32x4 v) const { uint2 o; o.x = pack2(v[0], v[1]); o.y = pack2(v[2], v[3]); *(uint2*)(O + (size_t)row * ldc + col) = o; }
};
struct EpiBf16P {
    static constexpr bool PAIRED = false, WHOLE = false, PERM = true, GU8 = false;
    bf16_t* O; int ldc;
    __device__ __forceinline__ void oct(int row, int col, f32x4 v0, f32x4 v1) const {
        uint4 o; o.x = pack2(v0[0], v0[1]); o.y = pack2(v0[2], v0[3]); o.z = pack2(v1[0], v1[1]); o.w = pack2(v1[2], v1[3]);
        *(uint4*)(O + (size_t)row * ldc + col) = o;
    }
};
struct EpiGU8 {
    static constexpr bool PAIRED = false, WHOLE = false, PERM = true, GU8 = true;
    bf16_t* H;
    __device__ __forceinline__ void gu8(int row, int ff, f32x4 g0, f32x4 g1, f32x4 u0, f32x4 u1) const {
        uint4 o;
        o.x = pack2(silu(g0[0]) * u0[0], silu(g0[1]) * u0[1]); o.y = pack2(silu(g0[2]) * u0[2], silu(g0[3]) * u0[3]);
        o.z = pack2(silu(g1[0]) * u1[0], silu(g1[1]) * u1[1]); o.w = pack2(silu(g1[2]) * u1[2], silu(g1[3]) * u1[3]);
        *(uint4*)(H + (size_t)row * 512 + ff) = o;
    }
};
struct EpiResid {
    static constexpr bool PAIRED = false, WHOLE = false, PERM = false;
    const float* R; float* O;
    __device__ __forceinline__ void operator()(int row, int col, f32x4 v) const {
        const float4 r = *(const float4*)(R + (size_t)row * D_ + col);
        *(float4*)(O + (size_t)row * D_ + col) = make_float4(ALPHA * r.x + v[0], ALPHA * r.y + v[1], ALPHA * r.z + v[2], ALPHA * r.w + v[3]);
    }
};
struct EpiResidBf {
    static constexpr bool PAIRED = false, WHOLE = false, PERM = false;
    const bf16_t* R; float* O;
    __device__ __forceinline__ void operator()(int row, int col, f32x4 v) const {
        const uint2 r = *(const uint2*)(R + (size_t)row * D_ + col);
        *(float4*)(O + (size_t)row * D_ + col) = make_float4(ALPHA * bf_lo(r.x) + v[0], ALPHA * bf_hi(r.x) + v[1], ALPHA * bf_lo(r.y) + v[2], ALPHA * bf_hi(r.y) + v[3]);
    }
};
struct EpiGU {
    static constexpr bool PAIRED = true, WHOLE = false, PERM = false;
    bf16_t* H;
    __device__ __forceinline__ void pair(int row, int col, f32x4 g, f32x4 u) const {
        const int ff = (col >> 5) * 16 + (col & 15);
        uint2 o; o.x = pack2(silu(g[0]) * u[0], silu(g[1]) * u[1]); o.y = pack2(silu(g[2]) * u[2], silu(g[3]) * u[3]);
        *(uint2*)(H + (size_t)row * 512 + ff) = o;
    }
    __device__ __forceinline__ void operator()(int row, int col, f32x4 v) const {
        f32x4 u; u[0] = __shfl_xor(v[0], 4); u[1] = __shfl_xor(v[1], 4); u[2] = __shfl_xor(v[2], 4); u[3] = __shfl_xor(v[3], 4);
        if ((col & 16) == 0) {
            const int ff = (col >> 5) * 16 + (col & 15);
            uint2 o; o.x = pack2(silu(v[0]) * u[0], silu(v[1]) * u[1]); o.y = pack2(silu(v[2]) * u[2], silu(v[3]) * u[3]);
            *(uint2*)(H + (size_t)row * 512 + ff) = o;
        }
    }
};

template <class Epi>
__device__ void gemm_phase_naive(const bf16_t* A, int lda, const bf16_t* Bt, int ldb, int M, int N, int K, const Epi& epi, float* sm) {
    const int tm = M / 64, tn = N / 64;
    for (int it = blockIdx.x; it < tm * tn; it += gridDim.x) gemm_tile64(A, lda, nullptr, (it / tn) * 64, Bt, ldb, (it % tn) * 64, K, epi, sm);
}


#define LAS __attribute__((address_space(3)))
typedef short bf16x8 __attribute__((ext_vector_type(8)));
template <class Epi>
__device__ __forceinline__ void gemm_tile128(const bf16_t* __restrict__ A, int lda, const int* __restrict__ rowidx, int row0,
                                             const bf16_t* __restrict__ Bt, int ldb, int col0, int K, const Epi& epi, float* sm, int nvalid = 128,
                                             bool pre = false, int nrow0 = -1, int ncol0 = 0) {
    LAS unsigned char* lds = (LAS unsigned char*)sm;
    const int tid = threadIdx.x, wid = __builtin_amdgcn_readfirstlane(tid >> 6), lane = tid & 63, wr = wid >> 1, wc = wid & 1, fr = lane & 15, fq = lane >> 4;
    const int r0 = tid >> 3, c8 = ((tid & 7) ^ ((tid >> 4) & 7)) * 8;
    const bf16_t* ap[4]; const bf16_t* bp[4];
#pragma unroll
    for (int i = 0; i < 4; ++i) {
        const int ar = rowidx ? ((r0 + i * 32 < nvalid) ? rowidx[r0 + i * 32] : 0) : row0 + r0 + i * 32;
        int br = r0 + i * 32;
        if constexpr (Epi::PERM) { const int q = br & 31; br = (br & ~31) + 8 * ((q & 15) >> 2) + 4 * (q >> 4) + (q & 3); }
        ap[i] = A + (size_t)ar * lda + c8; bp[i] = Bt + (size_t)(col0 + br) * ldb + c8;
    }
    const int g = (fr >> 1) & 7, sw0 = (fq ^ g) * 16, sw1 = ((fq ^ g) ^ 4) * 16;
    const int arow = (wr * 64 + fr) * 128, brow = 16384 + (wc * 64 + fr) * 128;
    f32x4 acc[4][4];
#pragma unroll
    for (int m = 0; m < 4; ++m)
#pragma unroll
        for (int n = 0; n < 4; ++n) acc[m][n] = (f32x4){0.f, 0.f, 0.f, 0.f};
#define GT_ISSUE(kt) do { const int st_ = ((kt) & 1) * 32768 + wid * 1024; _Pragma("unroll") for (int i = 0; i < 4; ++i) { \
        __builtin_amdgcn_global_load_lds((const unsigned*)(ap[i] + (kt) * 64), (LAS unsigned*)(lds + st_ + i * 4096), 16, 0, 0); \
        __builtin_amdgcn_global_load_lds((const unsigned*)(bp[i] + (kt) * 64), (LAS unsigned*)(lds + st_ + 16384 + i * 4096), 16, 0, 0); } } while (0)
    const int nk = K >> 6;
    const long dA = (long)(nrow0 - row0) * lda, dB = (long)(ncol0 - col0) * ldb;
    if (!pre) {
        __syncthreads();
        GT_ISSUE(0);
    }
    for (int kt = 0; kt < nk; ++kt) {
        asm volatile("s_waitcnt vmcnt(0) lgkmcnt(0)\n\ts_barrier" ::: "memory");
        if (kt + 1 < nk) GT_ISSUE(kt + 1);
        else if (nrow0 >= 0) {
#pragma unroll
            for (int i = 0; i < 4; ++i) {
                __builtin_amdgcn_global_load_lds((const unsigned*)(ap[i] + dA), (LAS unsigned*)(lds + wid * 1024 + i * 4096), 16, 0, 0);
                __builtin_amdgcn_global_load_lds((const unsigned*)(bp[i] + dB), (LAS unsigned*)(lds + wid * 1024 + 16384 + i * 4096), 16, 0, 0);
            }
        }
        const LAS unsigned char* sb = lds + (kt & 1) * 32768;
#pragma unroll
        for (int kh = 0; kh < 2; ++kh) {
            const int sw = kh ? sw1 : sw0;
            bf16x8 At[4], Bf[4];
#pragma unroll
            for (int m = 0; m < 4; ++m) At[m] = *(const LAS bf16x8*)(sb + arow + sw + m * 2048);
#pragma unroll
            for (int n = 0; n < 4; ++n) Bf[n] = *(const LAS bf16x8*)(sb + brow + sw + n * 2048);
#pragma unroll
            for (int m = 0; m < 4; ++m)
#pragma unroll
                for (int n = 0; n < 4; ++n) acc[m][n] = __builtin_amdgcn_mfma_f32_16x16x32_bf16(Bf[n], At[m], acc[m][n], 0, 0, 0);
        }
    }
#undef GT_ISSUE
    if constexpr (Epi::WHOLE) { epi.tile(acc, row0, col0, wr, wc, fr, fq); }
    else if constexpr (Epi::PERM) {
        if constexpr (Epi::GU8) {
#pragma unroll
            for (int m = 0; m < 4; ++m) epi.gu8(row0 + wr * 64 + m * 16 + fr, ((col0 + wc * 64) >> 6) * 32 + 8 * fq, acc[m][0], acc[m][1], acc[m][2], acc[m][3]);
        } else {
#pragma unroll
            for (int m = 0; m < 4; ++m)
#pragma unroll
                for (int n = 0; n < 4; n += 2) epi.oct(row0 + wr * 64 + m * 16 + fr, col0 + wc * 64 + (n >> 1) * 32 + 8 * fq, acc[m][n], acc[m][n + 1]);
        }
    }
    else {
#pragma unroll
    for (int m = 0; m < 4; ++m) {
        const int row = row0 + wr * 64 + m * 16 + fr;
        if constexpr (Epi::PAIRED) {
#pragma unroll
            for (int n = 0; n < 4; n += 2) epi.pair(row, col0 + wc * 64 + n * 16 + fq * 4, acc[m][n], acc[m][n + 1]);
        } else {
#pragma unroll
            for (int n = 0; n < 4; ++n) epi(row, col0 + wc * 64 + n * 16 + fq * 4, acc[m][n]);
        }
    }
    }
}

constexpr size_t OFF_G1 = OFF_MISC + 1010 * 1024;
__device__ __forceinline__ void row_stats(const float2* __restrict__ P, int row, int fq, float& mu, float& rstd) {
    const float2* ps = P + (size_t)row * 16 + fq * 4;
    const float2 a = ps[0], b = ps[1], c = ps[2], d = ps[3];
    float s1 = (a.x + b.x) + (c.x + d.x), s2 = (a.y + b.y) + (c.y + d.y);
    s1 += __shfl_xor(s1, 16); s1 += __shfl_xor(s1, 32); s2 += __shfl_xor(s2, 16); s2 += __shfl_xor(s2, 32);
    mu = s1 * (1.0f / 1024.0f); rstd = rsqrtf(s2 * (1.0f / 1024.0f) - mu * mu + LN_EPS);
}
struct EpiV1 {
    static constexpr bool PAIRED = false, WHOLE = true, PERM = true;
    const float* X; bf16_t* O; float2* P;
    __device__ __forceinline__ void tile(f32x4 (&acc)[4][4], int row0, int col0, int wr, int wc, int fr, int fq) const {
        const int slot = (col0 >> 7) * 2 + wc, rbase = row0 + wr * 64 + fr, cb = col0 + wc * 64 + 8 * fq;
#pragma unroll
        for (int m = 0; m < 4; ++m) {
            float s1 = 0.f, s2 = 0.f; const size_t ro = (size_t)(rbase + m * 16) * D_;
#pragma unroll
            for (int np = 0; np < 2; ++np) {
                const int c = cb + np * 32;
                const f32x4 xa_ = __builtin_nontemporal_load((const f32x4*)(X + ro + c)), xb_ = __builtin_nontemporal_load((const f32x4*)(X + ro + c + 4));
                const float4 xa = make_float4(xa_[0], xa_[1], xa_[2], xa_[3]), xb = make_float4(xb_[0], xb_[1], xb_[2], xb_[3]);
                const f32x4 a = acc[m][2 * np], b = acc[m][2 * np + 1];
                const float v0 = a[0] + ALPHA * xa.x, v1 = a[1] + ALPHA * xa.y, v2 = a[2] + ALPHA * xa.z, v3 = a[3] + ALPHA * xa.w;
                const float v4 = b[0] + ALPHA * xb.x, v5 = b[1] + ALPHA * xb.y, v6 = b[2] + ALPHA * xb.z, v7 = b[3] + ALPHA * xb.w;
                s1 += ((v0 + v1) + (v2 + v3)) + ((v4 + v5) + (v6 + v7));
                s2 += ((v0 * v0 + v1 * v1) + (v2 * v2 + v3 * v3)) + ((v4 * v4 + v5 * v5) + (v6 * v6 + v7 * v7));
                uint4 o; o.x = pack2(v0, v1); o.y = pack2(v2, v3); o.z = pack2(v4, v5); o.w = pack2(v6, v7); *(uint4*)(O + ro + c) = o;
            }
            s1 += __shfl_xor(s1, 16); s1 += __shfl_xor(s1, 32); s2 += __shfl_xor(s2, 16); s2 += __shfl_xor(s2, 32);
            if (fq == 0) P[(size_t)(rbase + m * 16) * 16 + slot] = make_float2(s1, s2);
        }
    }
};

struct EpiQ {
    static constexpr bool PAIRED = false, WHOLE = true, PERM = true;
    const float2* P; const float* GB; bf16_t* O;
    __device__ __forceinline__ void tile(f32x4 (&acc)[4][4], int row0, int col0, int wr, int wc, int fr, int fq) const {
        const int rbase = row0 + wr * 64 + fr, cb = col0 + wc * 64 + 8 * fq;
#pragma unroll
        for (int m = 0; m < 4; ++m) {
            float mu, rstd; row_stats(P, rbase + m * 16, fq, mu, rstd);
#pragma unroll
            for (int np = 0; np < 2; ++np) {
                const int c = cb + np * 32;
                const float4 g0 = *(const float4*)(GB + c), g1 = *(const float4*)(GB + c + 4), b0 = *(const float4*)(GB + 1024 + c), b1 = *(const float4*)(GB + 1024 + c + 4);
                const f32x4 a = acc[m][2 * np], b = acc[m][2 * np + 1];
                uint4 o;
                o.x = pack2(rstd * (a[0] - mu * g0.x) + b0.x, rstd * (a[1] - mu * g0.y) + b0.y);
                o.y = pack2(rstd * (a[2] - mu * g0.z) + b0.z, rstd * (a[3] - mu * g0.w) + b0.w);
                o.z = pack2(rstd * (b[0] - mu * g1.x) + b1.x, rstd * (b[1] - mu * g1.y) + b1.y);
                o.w = pack2(rstd * (b[2] - mu * g1.z) + b1.z, rstd * (b[3] - mu * g1.w) + b1.w);
                *(uint4*)(O + (size_t)(rbase + m * 16) * D_ + c) = o;
            }
        }
    }
};

struct EpiXO {
    static constexpr bool PAIRED = false, WHOLE = true, PERM = true;
    const float2* P; const bf16_t* V; const float* G; const float* Bv; float* O;
    __device__ __forceinline__ void tile(f32x4 (&acc)[4][4], int row0, int col0, int wr, int wc, int fr, int fq) const {
        const int rbase = row0 + wr * 64 + fr, cb = col0 + wc * 64 + 8 * fq;
#pragma unroll
        for (int m = 0; m < 4; ++m) {
            float mu, rstd; row_stats(P, rbase + m * 16, fq, mu, rstd);
            const size_t ro = (size_t)(rbase + m * 16) * D_;
#pragma unroll
            for (int np = 0; np < 2; ++np) {
                const int c = cb + np * 32;
                const float4 g0 = *(const float4*)(G + c), g1 = *(const float4*)(G + c + 4), b0 = *(const float4*)(Bv + c), b1 = *(const float4*)(Bv + c + 4);
                const uint4 v = *(const uint4*)(V + ro + c);
                const f32x4 a = acc[m][2 * np], b = acc[m][2 * np + 1];
                *(float4*)(O + ro + c) = make_float4(ALPHA * ((bf_lo(v.x) - mu) * rstd * g0.x + b0.x) + a[0], ALPHA * ((bf_hi(v.x) - mu) * rstd * g0.y + b0.y) + a[1],
                                                     ALPHA * ((bf_lo(v.y) - mu) * rstd * g0.z + b0.z) + a[2], ALPHA * ((bf_hi(v.y) - mu) * rstd * g0.w + b0.w) + a[3]);
                *(float4*)(O + ro + c + 4) = make_float4(ALPHA * ((bf_lo(v.z) - mu) * rstd * g1.x + b1.x) + b[0], ALPHA * ((bf_hi(v.z) - mu) * rstd * g1.y + b1.y) + b[1],
                                                         ALPHA * ((bf_lo(v.w) - mu) * rstd * g1.z + b1.z) + b[2], ALPHA * ((bf_hi(v.w) - mu) * rstd * g1.w + b1.w) + b[3]);
            }
        }
    }
};


template <class Epi>
__device__ __forceinline__ void gemm_phase_mfma(const bf16_t* A, int lda, const bf16_t* Bt, int ldb, int M, int N, int K, const Epi& epi, float* sm) {
    const int tm = M / 128, tn = N / 128;
    const int nt8 = (tm * tn) >> 3;
    for (int L = blockIdx.x; L < tm * tn; L += gridDim.x) { const int it = (L & 7) * nt8 + (L >> 3); gemm_tile128(A, lda, nullptr, (it / tn) * 128, Bt, ldb, (it % tn) * 128, K, epi, sm); }
}

typedef short v4i16_t __attribute__((ext_vector_type(4)));
typedef unsigned u32x2 __attribute__((ext_vector_type(2)));
__device__ __forceinline__ v4i16_t tr_read(const LAS unsigned char* a) { return __builtin_amdgcn_ds_read_tr16_b64_v4i16((LAS v4i16_t*)a); }
__device__ __forceinline__ bf16x8 cat8(v4i16_t lo, v4i16_t hi) { return (bf16x8){lo[0], lo[1], lo[2], lo[3], hi[0], hi[1], hi[2], hi[3]}; }
__device__ __forceinline__ bf16x8 pack8(f32x4 a, f32x4 b) {
    union { unsigned u[4]; bf16x8 v; } r;
    r.u[0] = pack2(a[0], a[1]); r.u[1] = pack2(a[2], a[3]); r.u[2] = pack2(b[0], b[1]); r.u[3] = pack2(b[2], b[3]);
    return r.v;
}

__device__ __constant__ float LOG2G[4] = {-0.04580368961312479f, -0.02272007650008353f, -0.011315313227834146f, -0.005646563141142063f};

__device__ void ret_kv_naive(const Params& p, float* sm) {
    const bf16_t* hb = (const bf16_t*)(p.ws + OFF_HB);
    const float2* rope = (const float2*)(p.ws + OFF_ROPE);
    float* KV = (float*)(p.ws + OFF_KV);
    float (*ks)[64] = (float (*)[64])sm;
    const int tid = threadIdx.x;
    for (int it = blockIdx.x; it < 512; it += gridDim.x) {
        const int b = it >> 8, h = (it >> 6) & 3, n = it & 63;
        const int t0 = b * S_ + n * 128;
        __syncthreads();
        for (int i = tid; i < 128 * 32; i += 256) {
            const int j = i >> 5, d = i & 31;
            const bf16_t* kr = hb + (size_t)(t0 + j) * 3072 + 256 + h * 64;
            const float k1 = bf2f(kr[d]), k2 = bf2f(kr[d + 32]);
            const float2 cs = rope[(n * 128 + j) * 32 + d];
            const float z = 0.125f * exp2f(LOG2G[h] * (float)(127 - j));
            ks[j][d] = (k1 * cs.x - k2 * cs.y) * z; ks[j][d + 32] = (k1 * cs.y + k2 * cs.x) * z;
        }
        __syncthreads();
        const int e = tid & 127, d0 = (tid >> 7) * 32;
        float acc[32];
#pragma unroll
        for (int i = 0; i < 32; ++i) acc[i] = 0.f;
        for (int j = 0; j < 128; ++j) {
            const float vj = bf2f(hb[(size_t)(t0 + j) * 3072 + 512 + h * 128 + e]);
#pragma unroll
            for (int i = 0; i < 32; ++i) acc[i] += ks[j][d0 + i] * vj;
        }
        float* o = KV + (size_t)it * 8192;
#pragma unroll
        for (int i = 0; i < 32; ++i) o[(d0 + i) * 128 + e] = acc[i];
    }
}
__device__ void ret_scan(const Params& p) {
    float* KV = (float*)(p.ws + OFF_KV);
    for (int g = blockIdx.x * 256 + threadIdx.x; g < 8 * 8192; g += gridDim.x * 256) {
        const int bh = g >> 13, idx = g & 8191, h = bh & 3;
        const float gc = exp2f(LOG2G[h] * 128.0f);
        float* q = KV + (size_t)bh * 64 * 8192 + idx;
        bf16_t* sb = (bf16_t*)((unsigned char*)p.out + 48 * MiB) + (size_t)bh * 64 * 8192 + idx;
        float kv[64];
#pragma unroll
        for (int n = 0; n < 64; ++n) kv[n] = q[(size_t)n * 8192];
        float st = 0.f;
#pragma unroll
        for (int n = 0; n < 64; ++n) { q[(size_t)n * 8192] = st; sb[(size_t)n * 8192] = (bf16_t)f2bf(st); st = gc * st + kv[n]; }
    }
}
__device__ void ret_out_naive(const Params& p, float* sm) {
    const bf16_t* hb = (const bf16_t*)(p.ws + OFF_HB);
    const float2* rope = (const float2*)(p.ws + OFF_ROPE);
    const float* KV = (const float*)(p.ws + OFF_KV);
    bf16_t* y = (bf16_t*)(p.ws + OFF_RB);
    float* qs = sm; float* ss = sm + 64; float* red = sm + 192;
    const int tid = threadIdx.x;
    for (int it = blockIdx.x; it < T_ * 4; it += gridDim.x) {
        const int t = it >> 2, h = it & 3, b = t >> 13, pos = t & 8191, n = pos >> 7, i = pos & 127;
        __syncthreads();
        if (tid < 32) {
            const bf16_t* qr = hb + (size_t)t * 3072 + h * 64;
            const float q1 = bf2f(qr[tid]), q2 = bf2f(qr[tid + 32]); const float2 cs = rope[pos * 32 + tid];
            qs[tid] = q1 * cs.x - q2 * cs.y; qs[tid + 32] = q1 * cs.y + q2 * cs.x;
        }
        __syncthreads();
        if (tid < 128) {
            const int j = tid; float s = 0.f;
            if (j <= i) {
                const int tj = t - i + j, pj = pos - i + j;
                const bf16_t* kr = hb + (size_t)tj * 3072 + 256 + h * 64;
                for (int d = 0; d < 32; ++d) {
                    const float k1 = bf2f(kr[d]), k2 = bf2f(kr[d + 32]); const float2 cs = rope[pj * 32 + d];
                    s += qs[d] * (k1 * cs.x - k2 * cs.y) + qs[d + 32] * (k1 * cs.y + k2 * cs.x);
                }
                s *= 0.125f * exp2f(LOG2G[h] * (float)(i - j));
            }
            ss[j] = s;
        }
        __syncthreads();
        float yv = 0.f;
        if (tid < 128) {
            const int e = tid;
            for (int j = 0; j <= i; ++j) yv += ss[j] * bf2f(hb[(size_t)(t - i + j) * 3072 + 512 + h * 128 + e]);
            const float* st = KV + ((size_t)((b * 4 + h) * 64 + n)) * 8192;
            float c = 0.f;
            for (int d = 0; d < 64; ++d) c += qs[d] * st[d * 128 + e];
            yv += c * exp2f(LOG2G[h] * (float)(i + 1));
        }
        float s1 = wave_sum(tid < 128 ? yv : 0.f);
        if ((tid & 63) == 0) red[tid >> 6] = s1;
        __syncthreads();
        const float mu = (red[0] + red[1]) * (1.0f / 128.0f);
        const float dv = yv - mu;
        float s2 = wave_sum(tid < 128 ? dv * dv : 0.f);
        if ((tid & 63) == 0) red[4 + (tid >> 6)] = s2;
        __syncthreads();
        const float var = (red[4] + red[5]) * (1.0f / 128.0f);
        if (tid < 128) {
            const float g = bf2f(hb[(size_t)t * 3072 + 1024 + h * 128 + tid]);
            y[(size_t)t * 1024 + h * 128 + tid] = (bf16_t)f2bf(silu(g) * dv * rsqrtf(var + GN_EPS));
        }
    }
}


constexpr size_t OFF_SB_IN_OUT = 48 * MiB;
__device__ __forceinline__ void rot8(const u32x4 lo, const u32x4 hi, const float2* __restrict__ rp, float z, u32x4& olo, u32x4& ohi) {
    float a[8], b[8];
#pragma unroll
    for (int i = 0; i < 4; ++i) { a[2 * i] = bf_lo(lo[i]); a[2 * i + 1] = bf_hi(lo[i]); b[2 * i] = bf_lo(hi[i]); b[2 * i + 1] = bf_hi(hi[i]); }
    float ra[8], rb[8];
#pragma unroll
    for (int i = 0; i < 8; ++i) { const float2 cs = rp[i]; ra[i] = (a[i] * cs.x - b[i] * cs.y) * z; rb[i] = (a[i] * cs.y + b[i] * cs.x) * z; }
#pragma unroll
    for (int i = 0; i < 4; ++i) { olo[i] = pack2(ra[2 * i], ra[2 * i + 1]); ohi[i] = pack2(rb[2 * i], rb[2 * i + 1]); }
}
__device__ void ret_kv_mfma(const Params& p, float* sm) {
    LAS unsigned char* lds = (LAS unsigned char*)sm;
    const bf16_t* hb = (const bf16_t*)(p.ws + OFF_HB);
    const float2* rope = (const float2*)(p.ws + OFF_ROPE);
    float* KV = (float*)(p.ws + OFF_KV);
    const int tid = threadIdx.x, wid = __builtin_amdgcn_readfirstlane(tid >> 6), lane = tid & 63, fr = lane & 15, fq = lane >> 4;
    for (int L = blockIdx.x; L < 1024; L += gridDim.x) {
        const int it = (L & 7) * 128 + (L >> 3);
        const int eh = it & 1, it3 = it >> 1, b = it3 >> 8, h = (it3 >> 6) & 3, n = it3 & 63;
        const int t0 = b * S_ + n * 128;
        __syncthreads();
#pragma unroll
        for (int i = 0; i < 2; ++i) {
            const int item = tid + 256 * i, j = item >> 2, c = item & 3;
            const bf16_t* kr = hb + (size_t)(t0 + j) * 3072 + 256 + h * 64 + 8 * c;
            const u32x4 lo = *(const u32x4*)kr, hi = *(const u32x4*)(kr + 32);
            u32x4 olo, ohi;
            rot8(lo, hi, rope + (size_t)(n * 128 + j) * 32 + 8 * c, 0.125f * exp2f(LOG2G[h] * (float)(127 - j)), olo, ohi);
            *(LAS u32x4*)(lds + j * 160 + c * 16) = olo; *(LAS u32x4*)(lds + j * 160 + 64 + c * 16) = ohi;
        }
#pragma unroll
        for (int i = 0; i < 4; ++i) {
            const int item = tid + 256 * i, j = item >> 3, ch = item & 7;
            *(LAS u32x4*)(lds + 20480 + j * 160 + ch * 16) = *(const u32x4*)(hb + (size_t)(t0 + j) * 3072 + 512 + h * 128 + eh * 64 + ch * 8);
        }
        __syncthreads();
        f32x4 acc[4];
#pragma unroll
        for (int dt = 0; dt < 4; ++dt) acc[dt] = (f32x4){0.f, 0.f, 0.f, 0.f};
#pragma unroll
        for (int ks = 0; ks < 4; ++ks) {
            const int rowoff = (32 * ks + 4 * fq + (fr >> 2)) * 160 + 8 * (fr & 3);
            const LAS unsigned char* ax = lds + 20480 + rowoff + 32 * wid;
            const bf16x8 xf = cat8(tr_read(ax), tr_read(ax + 16 * 160));
#pragma unroll
            for (int dt = 0; dt < 4; ++dt) {
                const LAS unsigned char* ay = lds + rowoff + 32 * dt;
                const bf16x8 yf = cat8(tr_read(ay), tr_read(ay + 16 * 160));
                acc[dt] = __builtin_amdgcn_mfma_f32_16x16x32_bf16(xf, yf, acc[dt], 0, 0, 0);
            }
        }
        float* o = KV + (size_t)it3 * 8192;
#pragma unroll
        for (int dt = 0; dt < 4; ++dt) *(f32x4*)(o + (16 * dt + fr) * 128 + eh * 64 + 16 * wid + 4 * fq) = acc[dt];
    }
}
__device__ void ret_out_mfma(const Params& p, float* sm) {
    LAS unsigned char* lds = (LAS unsigned char*)sm;
    const bf16_t* hb = (const bf16_t*)(p.ws + OFF_HB);
    const float2* rope = (const float2*)(p.ws + OFF_ROPE);
    const bf16_t* SB = (const bf16_t*)((const unsigned char*)p.out + OFF_SB_IN_OUT);
    bf16_t* y = (bf16_t*)(p.ws + OFF_RB);
    const int tid = threadIdx.x, wid = __builtin_amdgcn_readfirstlane(tid >> 6), lane = tid & 63, fr = lane & 15, fq = lane >> 4;
    for (int L = blockIdx.x; L < 1024; L += gridDim.x) {
        const int it = (L & 7) * 128 + (L >> 3);
        const int half = it & 1, it3 = it >> 1, b = it3 >> 8, h = (it3 >> 6) & 3, n = it3 & 63;
        const int t0 = b * S_ + n * 128;
        const int qt = (wid & 1) ? (8 - wid - half) : (wid + half);
        const float lg2 = LOG2G[h];
        __syncthreads();
#pragma unroll
        for (int i = 0; i < 2; ++i) {
            const int item = tid + 256 * i, j = item >> 2, c = item & 3;
            const bf16_t* kr = hb + (size_t)(t0 + j) * 3072 + 256 + h * 64 + 8 * c;
            const u32x4 lo = *(const u32x4*)kr, hi = *(const u32x4*)(kr + 32);
            u32x4 olo, ohi;
            rot8(lo, hi, rope + (size_t)(n * 128 + j) * 32 + 8 * c, 0.125f, olo, ohi);
            *(LAS u32x4*)(lds + j * 144 + c * 16) = olo; *(LAS u32x4*)(lds + j * 144 + 64 + c * 16) = ohi;
        }
#pragma unroll
        for (int i = 0; i < 4; ++i) {
            const int item = tid + 256 * i, d = item >> 4, ch = item & 15;
            *(LAS u32x4*)(lds + 18432 + d * 288 + ch * 16) = *(const u32x4*)(SB + (size_t)it3 * 8192 + d * 128 + ch * 8);
        }
        bf16x8 qf[2];
        const int qi = 16 * qt + fr;
        {
            const bf16_t* qr = hb + (size_t)(t0 + qi) * 3072 + h * 64 + 4 * fq;
            const uint2 a0 = *(const uint2*)qr, a1 = *(const uint2*)(qr + 16), b0 = *(const uint2*)(qr + 32), b1 = *(const uint2*)(qr + 48);
            const float2* rp = rope + (size_t)(n * 128 + qi) * 32 + 4 * fq;
            const float q1[8] = {bf_lo(a0.x), bf_hi(a0.x), bf_lo(a0.y), bf_hi(a0.y), bf_lo(a1.x), bf_hi(a1.x), bf_lo(a1.y), bf_hi(a1.y)};
            const float q2[8] = {bf_lo(b0.x), bf_hi(b0.x), bf_lo(b0.y), bf_hi(b0.y), bf_lo(b1.x), bf_hi(b1.x), bf_lo(b1.y), bf_hi(b1.y)};
            float r1[8], r2[8];
#pragma unroll
            for (int e = 0; e < 8; ++e) { const float2 cs = rp[e < 4 ? e : 12 + e]; r1[e] = q1[e] * cs.x - q2[e] * cs.y; r2[e] = q1[e] * cs.y + q2[e] * cs.x; }
            union { unsigned u[4]; bf16x8 v; } f0, f1;
#pragma unroll
            for (int e = 0; e < 4; ++e) { f0.u[e] = pack2(r1[2 * e], r1[2 * e + 1]); f1.u[e] = pack2(r2[2 * e], r2[2 * e + 1]); }
            qf[0] = f0.v; qf[1] = f1.v;
        }
        __syncthreads();
        f32x4 yacc[8];
#pragma unroll
        for (int et = 0; et < 8; ++et) yacc[et] = (f32x4){0.f, 0.f, 0.f, 0.f};
#pragma unroll
        for (int ks = 0; ks < 2; ++ks)
#pragma unroll
            for (int et = 0; et < 8; ++et) {
                const LAS unsigned char* a = lds + 18432 + (32 * ks + 4 * fq + (fr >> 2)) * 288 + 32 * et + 8 * (fr & 3);
                const bf16x8 sf = cat8(tr_read(a), tr_read(a + 16 * 288));
                yacc[et] = __builtin_amdgcn_mfma_f32_16x16x32_bf16(sf, qf[ks], yacc[et], 0, 0, 0);
            }
        {
            const float xi = __builtin_amdgcn_exp2f(lg2 * (float)(qi + 1));
#pragma unroll
            for (int et = 0; et < 8; ++et) yacc[et] *= xi;
        }
        f32x4 s[8];
#pragma unroll
        for (int nt = 0; nt < 8; ++nt) s[nt] = (f32x4){0.f, 0.f, 0.f, 0.f};
#pragma unroll
        for (int nt = 0; nt < 8; ++nt) {
            if (nt <= qt) {
#pragma unroll
                for (int ks = 0; ks < 2; ++ks) {
                    const LAS unsigned char* a = lds + (16 * nt + fr) * 144 + 64 * ks + 8 * fq;
                    const u32x2 k0 = *(const LAS u32x2*)a, k1 = *(const LAS u32x2*)(a + 32);
                    union { unsigned u[4]; bf16x8 v; } kf; kf.u[0] = k0.x; kf.u[1] = k0.y; kf.u[2] = k1.x; kf.u[3] = k1.y;
                    s[nt] = __builtin_amdgcn_mfma_f32_16x16x32_bf16(kf.v, qf[ks], s[nt], 0, 0, 0);
                }
            }
        }
#pragma unroll
        for (int nt = 0; nt < 8; ++nt)
#pragma unroll
            for (int rg = 0; rg < 4; ++rg) {
                const int j = 16 * nt + 4 * fq + rg;
                s[nt][rg] = j <= qi ? s[nt][rg] * __builtin_amdgcn_exp2f(lg2 * (float)(qi - j)) : 0.f;
            }
        bf16x8 pf[4];
#pragma unroll
        for (int c2 = 0; c2 < 4; ++c2) pf[c2] = pack8(s[2 * c2], s[2 * c2 + 1]);
        __syncthreads();
#pragma unroll
        for (int i = 0; i < 8; ++i) { const int item = tid + 256 * i, j = item >> 4, ch = item & 15; *(LAS u32x4*)(lds + j * 288 + ch * 16) = *(const u32x4*)(hb + (size_t)(t0 + j) * 3072 + 512 + h * 128 + ch * 8); }
        __syncthreads();
#pragma unroll
        for (int c2 = 0; c2 < 4; ++c2) {
            if (2 * c2 <= qt) {
#pragma unroll
                for (int et = 0; et < 8; ++et) {
                    const LAS unsigned char* a = lds + (32 * c2 + 4 * fq + (fr >> 2)) * 288 + 32 * et + 8 * (fr & 3);
                    const bf16x8 vf = cat8(tr_read(a), tr_read(a + 16 * 288));
                    yacc[et] = __builtin_amdgcn_mfma_f32_16x16x32_bf16(vf, pf[c2], yacc[et], 0, 0, 0);
                }
            }
        }
        {
            float s1 = 0.f;
#pragma unroll
            for (int et = 0; et < 8; ++et) s1 += (yacc[et][0] + yacc[et][1]) + (yacc[et][2] + yacc[et][3]);
            s1 += __shfl_xor(s1, 16); s1 += __shfl_xor(s1, 32);
            const float mu = s1 * (1.0f / 128.0f); float s2 = 0.f;
#pragma unroll
            for (int et = 0; et < 8; ++et) { yacc[et] -= mu; s2 += (yacc[et][0] * yacc[et][0] + yacc[et][1] * yacc[et][1]) + (yacc[et][2] * yacc[et][2] + yacc[et][3] * yacc[et][3]); }
            s2 += __shfl_xor(s2, 16); s2 += __shfl_xor(s2, 32);
            const float rstd = rsqrtf(s2 * (1.0f / 128.0f) + GN_EPS);
            const size_t t = (size_t)t0 + qi;
#pragma unroll
            for (int et = 0; et < 8; ++et) {
                const uint2 gv = *(const uint2*)(hb + t * 3072 + 1024 + h * 128 + 16 * et + 4 * fq);
                uint2 ov;
                ov.x = pack2(silu(bf_lo(gv.x)) * yacc[et][0] * rstd, silu(bf_hi(gv.x)) * yacc[et][1] * rstd);
                ov.y = pack2(silu(bf_lo(gv.y)) * yacc[et][2] * rstd, silu(bf_hi(gv.y)) * yacc[et][3] * rstd);
                *(uint2*)(y + t * 1024 + h * 128 + 16 * et + 4 * fq) = ov;
            }
        }
    }
}

__device__ void dil_naive(const Params& p) {
    const bf16_t* hb = (const bf16_t*)(p.ws + OFF_HB);
    bf16_t* odil = (bf16_t*)p.out;
    float* lse = (float*)(p.ws + OFF_LSE);
    const int lane = threadIdx.x & 63, wv = threadIdx.x >> 6;
    for (int it = blockIdx.x * 4 + wv; it < T_ * 8; it += gridDim.x * 4) {
        const int t = it >> 3, h = it & 7, pos = t & 8191;
        const float q = bf2f(hb[(size_t)t * 3072 + 1536 + h * 64 + lane]) * 0.125f;
#pragma unroll 1
        for (int c = 0; c < 3; ++c) {
            const int dil = c == 0 ? 1 : (c == 1 ? 4 : 16);
            float m = -1e30f, l = 0.f, acc = 0.f;
            for (int j = 0; j <= 128; ++j) {
                if (pos - j * dil < 0) break;
                const bf16_t* r = hb + (size_t)(t - j * dil) * 3072;
                const float s = wave_sum(q * bf2f(r[2048 + h * 64 + lane]));
                const float mn = fmaxf(m, s), sc = __expf(m - mn), pe = __expf(s - mn);
                l = l * sc + pe; acc = acc * sc + pe * bf2f(r[2560 + h * 64 + lane]); m = mn;
            }
            odil[((size_t)c * T_ + t) * 512 + h * 64 + lane] = (bf16_t)f2bf(acc / l);
            if (lane == 0) lse[((size_t)c * T_ + t) * 8 + h] = m + __logf(l);
        }
    }
}

__device__ void dil_mfma(const Params& p, float* sm) {
    LAS unsigned char* lds = (LAS unsigned char*)sm;
    const bf16_t* hb = (const bf16_t*)(p.ws + OFF_HB);
    bf16_t* odil = (bf16_t*)p.out;
    float* lse = (float*)(p.ws + OFF_LSE);
    const int tid = threadIdx.x, wid = __builtin_amdgcn_readfirstlane(tid >> 6), lane = tid & 63, fr = lane & 15, fq = lane >> 4, q0 = wid * 32;
    const float SC = 0.125f * 1.4426950408889634f;
#define DIL_DECODE(it_, br_, h_, n_, dil_, tb_) do { const int rem_ = (it_) & 1023, rn_ = rem_ & 63, dsh_ = ((it_) >> 10) * 2; br_ = (it_) >> 10; h_ = (rem_ >> 6) & 7; dil_ = 1 << dsh_; \
        n_ = rn_ >> dsh_; tb_ = (size_t)(rem_ >> 9) * 8192 + (rn_ & (dil_ - 1)); } while (0)
#define DIL_LOAD_KQ(h_, n_, dil_, tb_) do { _Pragma("unroll") for (int i = 0; i < 8; ++i) { int l_ = 128 * ((n_) - 1) + (tid >> 3) + 32 * i; l_ = l_ < 0 ? 0 : l_; \
            kreg[i] = *(const u32x4*)(hb + ((tb_) + (size_t)l_ * (dil_)) * 3072 + 2048 + (h_) * 64 + (tid & 7) * 8); } \
        _Pragma("unroll") for (int qt = 0; qt < 2; ++qt) _Pragma("unroll") for (int ks = 0; ks < 2; ++ks) { const int l_ = 128 * (n_) + q0 + 16 * qt + fr; \
            qf[qt][ks] = *(const bf16x8*)(hb + ((tb_) + (size_t)l_ * (dil_)) * 3072 + 1536 + (h_) * 64 + 32 * ks + 8 * fq); } } while (0)
    u32x4 kreg[8], vreg[8]; bf16x8 qf[2][2];
    int br = 0, h = 0, n = 0, dil = 1; size_t tb = 0;
#define DIL_MAP(L_) (((L_) & 7) * 384 + ((L_) >> 3))
    if ((int)blockIdx.x < 3072) { DIL_DECODE(DIL_MAP((int)blockIdx.x), br, h, n, dil, tb); DIL_LOAD_KQ(h, n, dil, tb); }
    for (int it = blockIdx.x; it < 3072; it += gridDim.x) {
        __syncthreads();
#pragma unroll
        for (int i = 0; i < 8; ++i) *(LAS u32x4*)(lds + ((tid >> 3) + 32 * i) * 144 + (tid & 7) * 16) = kreg[i];
        __syncthreads();
#pragma unroll
        for (int i = 0; i < 8; ++i) {
            int l = 128 * (n - 1) + (tid >> 3) + 32 * i; l = l < 0 ? 0 : l;
            vreg[i] = *(const u32x4*)(hb + (tb + (size_t)l * dil) * 3072 + 2560 + h * 64 + (tid & 7) * 8);
        }
        f32x4 s[2][10];
#pragma unroll
        for (int qt = 0; qt < 2; ++qt)
#pragma unroll
            for (int nt = 0; nt < 10; ++nt) s[qt][nt] = (f32x4){0.f, 0.f, 0.f, 0.f};
        __builtin_amdgcn_s_setprio(1);
#pragma unroll
        for (int nt = 0; nt < 10; ++nt)
#pragma unroll
            for (int ks = 0; ks < 2; ++ks) {
                const bf16x8 kf = *(const LAS bf16x8*)(lds + (q0 + 16 * nt + fr) * 144 + ks * 64 + fq * 16);
#pragma unroll
                for (int qt = 0; qt < 2; ++qt) s[qt][nt] = __builtin_amdgcn_mfma_f32_16x16x32_bf16(kf, qf[qt][ks], s[qt][nt], 0, 0, 0);
            }
        __builtin_amdgcn_s_setprio(0);
        __syncthreads();
#pragma unroll
        for (int i = 0; i < 8; ++i) *(LAS u32x4*)(lds + ((tid >> 3) + 32 * i) * 160 + (tid & 7) * 16) = vreg[i];
        const int itn = it + gridDim.x; int nbr = 0, nh = 0, nn = 0, ndil = 1; size_t ntb = 0;
        if (itn < 3072) { DIL_DECODE(DIL_MAP(itn), nbr, nh, nn, ndil, ntb); DIL_LOAD_KQ(nh, nn, ndil, ntb); }
        float mrow[2], lrow[2];
#pragma unroll
        for (int qt = 0; qt < 2; ++qt) {
            float m = -1e30f;
#pragma unroll
            for (int nt = 0; nt < 10; ++nt)
#pragma unroll
                for (int rg = 0; rg < 4; ++rg) {
                    const int diff = 16 * (nt - qt) + 4 * fq + rg - fr, kj = q0 + 16 * nt + 4 * fq + rg;
                    const bool valid = diff >= 0 && diff <= 128 && (n > 0 || kj >= 128);
                    const float v = valid ? s[qt][nt][rg] * SC : -1e30f;
                    s[qt][nt][rg] = v; m = fmaxf(m, v);
                }
            m = fmaxf(m, __shfl_xor(m, 16)); m = fmaxf(m, __shfl_xor(m, 32));
            float l = 0.f;
#pragma unroll
            for (int nt = 0; nt < 10; ++nt)
#pragma unroll
                for (int rg = 0; rg < 4; ++rg) { const float pe = __builtin_amdgcn_exp2f(s[qt][nt][rg] - m); s[qt][nt][rg] = pe; l += pe; }
            l += __shfl_xor(l, 16); l += __shfl_xor(l, 32);
            mrow[qt] = m; lrow[qt] = l;
        }
        __syncthreads();
        f32x4 o[2][4];
#pragma unroll
        for (int qt = 0; qt < 2; ++qt)
#pragma unroll
            for (int dt = 0; dt < 4; ++dt) o[qt][dt] = (f32x4){0.f, 0.f, 0.f, 0.f};
        __builtin_amdgcn_s_setprio(1);
#pragma unroll
        for (int c2 = 0; c2 < 5; ++c2) {
            bf16x8 pf[2];
#pragma unroll
            for (int qt = 0; qt < 2; ++qt) pf[qt] = pack8(s[qt][2 * c2], s[qt][2 * c2 + 1]);
#pragma unroll
            for (int dt = 0; dt < 4; ++dt) {
                const LAS unsigned char* a = lds + (q0 + 32 * c2 + 4 * fq + (fr >> 2)) * 160 + (16 * dt + 4 * (fr & 3)) * 2;
                const bf16x8 vf = cat8(tr_read(a), tr_read(a + 16 * 160));
#pragma unroll
                for (int qt = 0; qt < 2; ++qt) o[qt][dt] = __builtin_amdgcn_mfma_f32_16x16x32_bf16(vf, pf[qt], o[qt][dt], 0, 0, 0);
            }
        }
        __builtin_amdgcn_s_setprio(0);
#pragma unroll
        for (int qt = 0; qt < 2; ++qt) {
            const int l = 128 * n + q0 + 16 * qt + fr; const size_t t = tb + (size_t)l * dil; const float inv = 1.0f / lrow[qt];
#pragma unroll
            for (int dt = 0; dt < 4; ++dt) {
                uint2 ov; ov.x = pack2(o[qt][dt][0] * inv, o[qt][dt][1] * inv); ov.y = pack2(o[qt][dt][2] * inv, o[qt][dt][3] * inv);
                *(uint2*)(odil + ((size_t)br * T_ + t) * 512 + h * 64 + 16 * dt + 4 * fq) = ov;
            }
            if (fq == 0) lse[((size_t)br * T_ + t) * 8 + h] = (mrow[qt] + __log2f(lrow[qt])) * 0.6931471805599453f;
        }
        br = nbr; h = nh; n = nn; dil = ndil; tb = ntb;
    }
#undef DIL_DECODE
#undef DIL_MAP
#undef DIL_LOAD_KQ
}

__device__ void dil_merge(const Params& p) {
    const bf16_t* odil = (const bf16_t*)p.out;
    const float* lse = (const float*)(p.ws + OFF_LSE);
    bf16_t* y = (bf16_t*)(p.ws + OFF_RB);
    for (int g = blockIdx.x * 256 + threadIdx.x; g < T_ * 64; g += gridDim.x * 256) {
        const int t = g >> 6, c8 = (g & 63) * 8, h = c8 >> 6;
        const float l0 = lse[(size_t)t * 8 + h], l1 = lse[((size_t)T_ + t) * 8 + h], l2 = lse[((size_t)2 * T_ + t) * 8 + h];
        const uint4 a = *(const uint4*)(odil + (size_t)t * 512 + c8), b = *(const uint4*)(odil + ((size_t)T_ + t) * 512 + c8), c = *(const uint4*)(odil + ((size_t)2 * T_ + t) * 512 + c8);
        const float mx = fmaxf(l0, fmaxf(l1, l2));
        float w0 = __expf(l0 - mx), w1 = __expf(l1 - mx), w2 = __expf(l2 - mx); const float inv = 1.0f / (w0 + w1 + w2); w0 *= inv; w1 *= inv; w2 *= inv;
        const unsigned aw[4] = {a.x, a.y, a.z, a.w}, bw[4] = {b.x, b.y, b.z, b.w}, cw[4] = {c.x, c.y, c.z, c.w};
        unsigned ow[4];
#pragma unroll
        for (int j = 0; j < 4; ++j) ow[j] = pack2(w0 * bf_lo(aw[j]) + w1 * bf_lo(bw[j]) + w2 * bf_lo(cw[j]), w0 * bf_hi(aw[j]) + w1 * bf_hi(bw[j]) + w2 * bf_hi(cw[j]));
        *(uint4*)(y + (size_t)t * 1024 + 512 + c8) = make_uint4(ow[0], ow[1], ow[2], ow[3]);
    }
}

template <bool ROUTE>
__device__ void ln_pass(const Params& p, const float* __restrict__ v, const float* __restrict__ g, const float* __restrict__ bta, float* __restrict__ of, bf16_t* __restrict__ ob, float* sm) {
    const int lane = threadIdx.x & 63, wv = threadIdx.x >> 6;
    for (int row = blockIdx.x * 4 + wv; row < T_; row += gridDim.x * 4) {
        float4 a[4]; float s = 0.f;
#pragma unroll
        for (int i = 0; i < 4; ++i) { a[i] = *(const float4*)(v + (size_t)row * D_ + i * 256 + lane * 4); s += (a[i].x + a[i].y) + (a[i].z + a[i].w); }
        const float mu = wave_sum(s) * (1.0f / 1024.0f); float q = 0.f;
#pragma unroll
        for (int i = 0; i < 4; ++i) { a[i].x -= mu; a[i].y -= mu; a[i].z -= mu; a[i].w -= mu; q += (a[i].x * a[i].x + a[i].y * a[i].y) + (a[i].z * a[i].z + a[i].w * a[i].w); }
        const float rstd = rsqrtf(wave_sum(q) * (1.0f / 1024.0f) + LN_EPS);
#pragma unroll
        for (int i = 0; i < 4; ++i) {
            const int c = i * 256 + lane * 4; const float4 gg = *(const float4*)(g + c), bb = *(const float4*)(bta + c);
            a[i].x = a[i].x * rstd * gg.x + bb.x; a[i].y = a[i].y * rstd * gg.y + bb.y; a[i].z = a[i].z * rstd * gg.z + bb.z; a[i].w = a[i].w * rstd * gg.w + bb.w;
            if (of) *(float4*)(of + (size_t)row * D_ + c) = a[i];
            uint2 o; o.x = pack2(a[i].x, a[i].y); o.y = pack2(a[i].z, a[i].w); *(uint2*)(ob + (size_t)row * D_ + c) = o;
        }
        if (ROUTE) {
            float lg[36];
#pragma unroll
            for (int c = 0; c < 36; ++c) lg[c] = 0.f;
            float* xr = sm + wv * 1024;
#pragma unroll
            for (int i = 0; i < 4; ++i) *(float4*)(xr + i * 256 + lane * 4) = a[i];
            asm volatile("" ::: "memory");
#pragma unroll 1
            for (int kk = 0; kk < 16; ++kk) {
                const int k = kk * 64 + lane; const float xv = xr[k];
                const float4 wg = *(const float4*)(p.w_rg + (size_t)k * 4);
                lg[0] += xv * wg.x; lg[1] += xv * wg.y; lg[2] += xv * wg.z; lg[3] += xv * wg.w;
#pragma unroll
                for (int c = 0; c < 8; ++c) {
                    const float4 we = *(const float4*)(p.w_re + (size_t)k * 32 + c * 4);
                    lg[4 + c * 4] += xv * we.x; lg[5 + c * 4] += xv * we.y; lg[6 + c * 4] += xv * we.z; lg[7 + c * 4] += xv * we.w;
                }
            }
            asm volatile("" ::: "memory");
#pragma unroll
            for (int c = 0; c < 36; ++c) lg[c] = wave_sum(lg[c]);
            int gi = 0; float gm = lg[0];
#pragma unroll
            for (int c = 1; c < 4; ++c) if (lg[c] > gm) { gm = lg[c]; gi = c; }
            float den = 0.f;
#pragma unroll
            for (int c = 0; c < 4; ++c) den += __expf(lg[c] - gm);
            const float g1 = 1.0f / den;
            float ev[8];
#pragma unroll
            for (int c = 0; c < 8; ++c) ev[c] = gi == 0 ? lg[4 + c] : (gi == 1 ? lg[12 + c] : (gi == 2 ? lg[20 + c] : lg[28 + c]));
            int i1 = 0; float v1 = ev[0];
#pragma unroll
            for (int c = 1; c < 8; ++c) if (ev[c] > v1) { v1 = ev[c]; i1 = c; }
            int i2 = -1; float v2 = -3.0e38f;
#pragma unroll
            for (int c = 0; c < 8; ++c) if (c != i1 && ev[c] > v2) { v2 = ev[c]; i2 = c; }
            const float e2 = __expf(v2 - v1), ga = g1 / (1.0f + e2), gb = g1 * e2 / (1.0f + e2);
            if (lane == 0) {
                int* cnt = (int*)(p.ws + OFF_CNT); int* eid = (int*)(p.ws + OFF_EID); float* gate = (float*)(p.ws + OFF_GATE); int* rank = (int*)(p.ws + OFF_RANK);
                const int ea = gi * 8 + i1, eb = gi * 8 + i2;
                eid[row * 2] = ea; eid[row * 2 + 1] = eb; gate[row * 2] = ga; gate[row * 2 + 1] = gb;
                rank[row * 2] = atomicAdd(cnt + ea, 1); rank[row * 2 + 1] = atomicAdd(cnt + eb, 1);
            }
        }
    }
}


constexpr size_t OFF_WR = OFF_MISC + 816 * 1024;
__device__ void route_prep(const Params& p, int vb, int nvb) {
    float* Wp = (float*)(p.ws + OFF_WR);
    for (int i = vb * 256 + threadIdx.x; i < 1024 * 48; i += nvb * 256) {
        const int k = i / 48, cc = i % 48, cgp = cc / 12, cl = cc % 12, c = cgp * 9 + cl;
        Wp[i] = cl < 9 ? p.ln_x_g[k] * (c < 4 ? p.w_rg[k * 4 + c] : p.w_re[k * 32 + c - 4]) : 0.f;
    }
    if (vb < 36 && threadIdx.x < 64) {
        const int c = vb, l = threadIdx.x; float G = 0.f, B = 0.f;
#pragma unroll
        for (int j = 0; j < 16; ++j) { const int k = j * 64 + l; const float w = c < 4 ? p.w_rg[k * 4 + c] : p.w_re[k * 32 + c - 4]; G += p.ln_x_g[k] * w; B += p.ln_x_b[k] * w; }
        G = wave_sum(G); B = wave_sum(B);
        if (l == 0) { Wp[1024 * 48 + c] = G; Wp[1024 * 48 + 36 + c] = B; }
    }
}

__device__ void deferred_prep(const Params& p, float* sm, int vb, int nvb) {
    route_prep(p, vb, nvb);
    transpose_tiles(p.w_out, 1024, 1024, 1, (bf16_t*)(p.ws + OFF_WOUT), 0, 0, sm, nullptr, vb, nvb);
    transpose_tiles(p.w_xq, 1024, 1024, 1, (bf16_t*)(p.ws + OFF_WXQ), 0, 0, sm, p.ln_mix_g, vb, nvb);
    transpose_tiles(p.w_xo, 1024, 1024, 1, (bf16_t*)(p.ws + OFF_WXO), 0, 0, sm, nullptr, vb, nvb);
    if (vb < 64) {
        const int t = threadIdx.x, col = vb * 16 + (t & 15), kg = t >> 4; float G = 0.f, B = 0.f;
#pragma unroll 8
        for (int k = kg * 64; k < kg * 64 + 64; ++k) { const float w = p.w_xq[(size_t)k * 1024 + col]; G += p.ln_mix_g[k] * w; B += p.ln_mix_b[k] * w; }
        __syncthreads();
        sm[t * 2] = G; sm[t * 2 + 1] = B;
        __syncthreads();
        if (t < 16) { float g = 0.f, b = 0.f; for (int q = 0; q < 16; ++q) { g += sm[(q * 16 + t) * 2]; b += sm[(q * 16 + t) * 2 + 1]; }
            float* gb = (float*)(p.ws + OFF_MISC + 1010 * 1024); gb[col] = g; gb[1024 + col] = b; }
        __syncthreads();
    }
}

__device__ void route_tasks(const Params& p, const float* __restrict__ v, float* sm) {
    float* As = sm;
    float* LG = sm + 2112;
    float* ST = sm + 4480;
    int* cntl = (int*)(sm + 4608);
    int* basel = (int*)(sm + 4640);
    float* Ws = sm + 4672;
    const float* __restrict__ Wp = (const float*)(p.ws + OFF_WR);
    const float* __restrict__ GB = Wp + 1024 * 48;
    int* cnt = (int*)(p.ws + OFF_CNT); int* eid = (int*)(p.ws + OFF_EID); float* gate = (float*)(p.ws + OFF_GATE); int* rank = (int*)(p.ws + OFF_RANK);
    const int tid = threadIdx.x, r = tid & 31, cg = (tid >> 5) & 3, kh = tid >> 7;
    for (int it = blockIdx.x; it < T_ / 32; it += gridDim.x) {
        const int row0 = it * 32;
        float acc[9]; float s1 = 0.f, s2 = 0.f;
#pragma unroll
        for (int c = 0; c < 9; ++c) acc[c] = 0.f;
        for (int k0 = 0; k0 < 1024; k0 += 64) {
            __syncthreads();
#pragma unroll
            for (int i = 0; i < 2; ++i) {
                const int idx = tid + 256 * i, row = idx >> 4, c4 = idx & 15;
                const float4 a = *(const float4*)(v + (size_t)(row0 + row) * 1024 + k0 + c4 * 4);
                float* d = As + row * 65 + c4 * 4; d[0] = a.x; d[1] = a.y; d[2] = a.z; d[3] = a.w;
            }
#pragma unroll
            for (int i = 0; i < 3; ++i) *(float4*)(Ws + (tid + 256 * i) * 4) = *(const float4*)(Wp + (size_t)k0 * 48 + (tid + 256 * i) * 4);
            __syncthreads();
            const float* wk = Ws + (kh * 32) * 48 + cg * 12; const float* ak = As + r * 65 + kh * 32;
#pragma unroll 8
            for (int k = 0; k < 32; ++k) {
                const float a = ak[k]; s1 += a; s2 += a * a;
                const float4 w0 = *(const float4*)(wk + k * 48), w1 = *(const float4*)(wk + k * 48 + 4); const float w8 = wk[k * 48 + 8];
                acc[0] += a * w0.x; acc[1] += a * w0.y; acc[2] += a * w0.z; acc[3] += a * w0.w;
                acc[4] += a * w1.x; acc[5] += a * w1.y; acc[6] += a * w1.z; acc[7] += a * w1.w; acc[8] += a * w8;
            }
        }
#pragma unroll
        for (int c = 0; c < 9; ++c) LG[(kh * 32 + r) * 37 + cg * 9 + c] = acc[c];
        if (cg == 0) { ST[(kh * 32 + r) * 2] = s1; ST[(kh * 32 + r) * 2 + 1] = s2; }
        if (tid < 32) cntl[tid] = 0;
        __syncthreads();
        int ea = 0, eb = 0, ra = 0, rb = 0; float ga = 0.f, gb = 0.f;
        if (tid < 32) {
            const float t1 = ST[tid * 2] + ST[(32 + tid) * 2], t2 = ST[tid * 2 + 1] + ST[(32 + tid) * 2 + 1];
            const float mu = t1 * (1.0f / 1024.0f), rstd = rsqrtf(t2 * (1.0f / 1024.0f) - mu * mu + LN_EPS);
            float lg[36];
#pragma unroll
            for (int c = 0; c < 36; ++c) lg[c] = rstd * ((LG[tid * 37 + c] + LG[(32 + tid) * 37 + c]) - mu * GB[c]) + GB[36 + c];
            int gi = 0; float gm = lg[0];
#pragma unroll
            for (int c = 1; c < 4; ++c) if (lg[c] > gm) { gm = lg[c]; gi = c; }
            float den = 0.f;
#pragma unroll
            for (int c = 0; c < 4; ++c) den += __expf(lg[c] - gm);
            const float g1 = 1.0f / den;
            float ev[8];
#pragma unroll
            for (int c = 0; c < 8; ++c) ev[c] = gi == 0 ? lg[4 + c] : (gi == 1 ? lg[12 + c] : (gi == 2 ? lg[20 + c] : lg[28 + c]));
            int i1 = 0; float v1 = ev[0];
#pragma unroll
            for (int c = 1; c < 8; ++c) if (ev[c] > v1) { v1 = ev[c]; i1 = c; }
            int i2 = -1; float v2 = -3.0e38f;
#pragma unroll
            for (int c = 0; c < 8; ++c) if (c != i1 && ev[c] > v2) { v2 = ev[c]; i2 = c; }
            const float e2 = __expf(v2 - v1); ga = g1 / (1.0f + e2); gb = g1 * e2 / (1.0f + e2);
            ea = gi * 8 + i1; eb = gi * 8 + i2;
            ra = atomicAdd(cntl + ea, 1); rb = atomicAdd(cntl + eb, 1);
        }
        __syncthreads();
        if (tid < 32) { const int c = cntl[tid]; basel[tid] = c ? atomicAdd(cnt + tid, c) : 0; }
        __syncthreads();
        if (tid < 32) {
            const int row = row0 + tid;
            eid[row * 2] = ea; eid[row * 2 + 1] = eb; gate[row * 2] = ga; gate[row * 2 + 1] = gb;
            const int rka = basel[ea] + ra, rkb = basel[eb] + rb;
            rank[row * 2] = rka; rank[row * 2 + 1] = rkb;
            int* rte = (int*)(p.ws + OFF_ROPE);
            rte[ea * 16384 + rka] = row; rte[eb * 16384 + rkb] = row;
        }
    }
}

__device__ void xattn_naive(const Params& p, float* sm) {
    const bf16_t* qx = (const bf16_t*)(p.ws + OFF_RB);
    const bf16_t* kvb = (const bf16_t*)(p.ws + OFF_KVB);
    bf16_t* ob = (bf16_t*)(p.ws + OFF_OB);
    float* qs = sm; float* ps = sm + 256; float* red = sm + 512;
    const int tid = threadIdx.x;
    for (int it = blockIdx.x; it < T_ * 4; it += gridDim.x) {
        const int t = it >> 2, h = it & 3, b = t >> 13;
        __syncthreads();
        qs[tid] = bf2f(qx[(size_t)t * 1024 + h * 256 + tid]);
        __syncthreads();
        const bf16_t* kr = kvb + (size_t)(b * 256 + tid) * 2048 + h * 256;
        float s = 0.f;
        for (int d = 0; d < 256; d += 2) { const unsigned u = *(const unsigned*)(kr + d); s += qs[d] * bf_lo(u) + qs[d + 1] * bf_hi(u); }
        s *= 0.0625f;
        const float wm = wave_max(s);
        if ((tid & 63) == 0) red[tid >> 6] = wm;
        __syncthreads();
        const float mx = fmaxf(fmaxf(red[0], red[1]), fmaxf(red[2], red[3]));
        const float pe = __expf(s - mx);
        ps[tid] = pe;
        const float ws_ = wave_sum(pe);
        if ((tid & 63) == 0) red[4 + (tid >> 6)] = ws_;
        __syncthreads();
        const float den = (red[4] + red[5]) + (red[6] + red[7]);
        float o = 0.f;
        const bf16_t* vr = kvb + (size_t)(b * 256) * 2048 + 1024 + h * 256 + tid;
        for (int m = 0; m < 256; ++m) o += ps[m] * bf2f(vr[(size_t)m * 2048]);
        ob[(size_t)t * 1024 + h * 256 + tid] = (bf16_t)f2bf(o / den);
    }
}


template <int NQT>
__device__ void xattn_mfma(const Params& p, float* sm) {
    LAS unsigned char* lds = (LAS unsigned char*)sm;
    const bf16_t* qx = (const bf16_t*)(p.ws + OFF_RB);
    const bf16_t* kvb = (const bf16_t*)(p.ws + OFF_KVB);
    bf16_t* ob = (bf16_t*)(p.ws + OFF_OB);
    const int tid = threadIdx.x, wid = __builtin_amdgcn_readfirstlane(tid >> 6), lane = tid & 63, fr = lane & 15, fq = lane >> 4;
    constexpr int QROWS = 64 * NQT, NTASK = (T_ / QROWS) * 4;
    const float SC = 0.0625f * 1.4426950408889634f;
    for (int it = blockIdx.x; it < NTASK; it += gridDim.x) {
        const int h = it & 3, t0 = (it >> 2) * QROWS, b = t0 >> 13;
        const bf16_t* kbase = kvb + (size_t)(b * 256 + (tid >> 5)) * 2048 + h * 256 + (tid & 31) * 8;
        u32x4 regs[8];
#pragma unroll
        for (int i = 0; i < 8; ++i) regs[i] = *(const u32x4*)(kbase + (size_t)(8 * i) * 2048);
        bf16x8 qf[NQT][8];
#pragma unroll
        for (int qt = 0; qt < NQT; ++qt)
#pragma unroll
            for (int ks = 0; ks < 8; ++ks) qf[qt][ks] = *(const bf16x8*)(qx + (size_t)(t0 + (wid * NQT + qt) * 16 + fr) * 1024 + h * 256 + 32 * ks + 8 * fq);
        f32x4 s[NQT][16];
        f32x4 o[NQT][16];
        float lrow[NQT];
#pragma unroll
        for (int qt = 0; qt < NQT; ++qt)
#pragma unroll
            for (int g = 0; g < 16; ++g) { s[qt][g] = (f32x4){0.f, 0.f, 0.f, 0.f}; o[qt][g] = (f32x4){0.f, 0.f, 0.f, 0.f}; }
#pragma unroll
        for (int st = 0; st < 8; ++st) {
            const int rs = st < 4 ? 528 : 544;
            __syncthreads();
#pragma unroll
            for (int i = 0; i < 8; ++i) *(LAS u32x4*)(lds + ((tid >> 5) + 8 * i) * rs + (tid & 31) * 16) = regs[i];
            __syncthreads();
            if (st < 7) {
                const int nx = st + 1; const bf16_t* nb = kbase + (size_t)((nx & 3) * 64) * 2048 + (nx >= 4 ? 1024 : 0);
#pragma unroll
                for (int i = 0; i < 8; ++i) regs[i] = *(const u32x4*)(nb + (size_t)(8 * i) * 2048);
            }
            if (st < 4) {
                __builtin_amdgcn_s_setprio(1);
#pragma unroll
                for (int nt = 0; nt < 4; ++nt)
#pragma unroll
                    for (int ks = 0; ks < 8; ++ks) {
                        const bf16x8 kf = *(const LAS bf16x8*)(lds + (16 * nt + fr) * 528 + ks * 64 + fq * 16);
#pragma unroll
                        for (int qt = 0; qt < NQT; ++qt) s[qt][st * 4 + nt] = __builtin_amdgcn_mfma_f32_16x16x32_bf16(kf, qf[qt][ks], s[qt][st * 4 + nt], 0, 0, 0);
                    }
                __builtin_amdgcn_s_setprio(0);
                if (st == 3) {
#pragma unroll
                    for (int qt = 0; qt < NQT; ++qt) {
                        float m = -1e30f;
#pragma unroll
                        for (int g = 0; g < 16; ++g)
#pragma unroll
                            for (int rg = 0; rg < 4; ++rg) { const float v = s[qt][g][rg] * SC; s[qt][g][rg] = v; m = fmaxf(m, v); }
                        m = fmaxf(m, __shfl_xor(m, 16)); m = fmaxf(m, __shfl_xor(m, 32));
                        float l = 0.f;
#pragma unroll
                        for (int g = 0; g < 16; ++g)
#pragma unroll
                            for (int rg = 0; rg < 4; ++rg) { const float pe = __builtin_amdgcn_exp2f(s[qt][g][rg] - m); s[qt][g][rg] = pe; l += pe; }
                        l += __shfl_xor(l, 16); l += __shfl_xor(l, 32);
                        lrow[qt] = l;
                    }
                }
            } else {
                const int vc = st - 4;
                __builtin_amdgcn_s_setprio(1);
#pragma unroll
                for (int c2 = 0; c2 < 2; ++c2) {
                    bf16x8 pf[NQT];
#pragma unroll
                    for (int qt = 0; qt < NQT; ++qt) pf[qt] = pack8(s[qt][2 * (vc * 2 + c2)], s[qt][2 * (vc * 2 + c2) + 1]);
#pragma unroll
                    for (int dt = 0; dt < 16; ++dt) {
                        const LAS unsigned char* a = lds + (32 * c2 + 4 * fq + (fr >> 2)) * 544 + (16 * dt + 4 * (fr & 3)) * 2;
                        const bf16x8 vf = cat8(tr_read(a), tr_read(a + 16 * 544));
#pragma unroll
                        for (int qt = 0; qt < NQT; ++qt) o[qt][dt] = __builtin_amdgcn_mfma_f32_16x16x32_bf16(vf, pf[qt], o[qt][dt], 0, 0, 0);
                    }
                }
                __builtin_amdgcn_s_setprio(0);
            }
        }
#pragma unroll
        for (int qt = 0; qt < NQT; ++qt) {
            const float inv = 1.0f / lrow[qt];
            bf16_t* orow = ob + (size_t)(t0 + (wid * NQT + qt) * 16 + fr) * 1024 + h * 256 + 4 * fq;
#pragma unroll
            for (int dt = 0; dt < 16; ++dt) {
                uint2 ov; ov.x = pack2(o[qt][dt][0] * inv, o[qt][dt][1] * inv); ov.y = pack2(o[qt][dt][2] * inv, o[qt][dt][3] * inv);
                *(uint2*)(orow + 16 * dt) = ov;
            }
        }
    }
}

__device__ void moe_dest(const Params& p, float* sm) {
    const int* cnt = (const int*)(p.ws + OFF_CNT); const int* eid = (const int*)(p.ws + OFF_EID); const int* rank = (const int*)(p.ws + OFF_RANK);
    int* dest = (int*)(p.ws + OFF_DEST); int* rtok = (int*)(p.ws + OFF_RTOK);
    int* poff = (int*)sm;
    __syncthreads();
    if (threadIdx.x < 64) {
        const int l = threadIdx.x; const int pc = l < 32 ? ((cnt[l & 31] + 127) & ~127) : 0; int incl = pc;
#pragma unroll
        for (int o = 1; o < 32; o <<= 1) { const int t = __shfl_up(incl, o); if (l >= o) incl += t; }
        if (l < 32) poff[l] = incl - pc;
    }
    __syncthreads();
    for (int a = blockIdx.x * 256 + threadIdx.x; a < T_ * 2; a += gridDim.x * 256) {
        const int d = poff[eid[a]] + rank[a];
        dest[a] = d; rtok[d] = a >> 1;
    }
}
__device__ __forceinline__ int padded_end_lane(const int* cnt) {
    const int l = threadIdx.x & 63; const int pc = l < 32 ? ((cnt[l & 31] + 127) & ~127) : 0; int incl = pc;
#pragma unroll
    for (int o = 1; o < 32; o <<= 1) { const int t = __shfl_up(incl, o); if (l >= o) incl += t; }
    return l < 32 ? incl : 0x7fffffff;
}
__device__ __forceinline__ int tile_expert(int pend, int row0) {
    const int e = __popcll(__ballot(pend <= row0));
    return e < 32 ? e : -1;
}
__device__ void moe_gu_naive(const Params& p, float* sm) {
    const int* cnt = (const int*)(p.ws + OFF_CNT); const int* rtok = (const int*)(p.ws + OFF_ROPE);
    const bf16_t* x2b = (const bf16_t*)(p.ws + OFF_RB); const bf16_t* W = (const bf16_t*)(p.ws + OFF_WGU);
    EpiGU8 epi{(bf16_t*)(p.ws + OFF_HEXP)};
    const int pend = padded_end_lane(cnt);
    const int ntv = (__shfl(pend, 31) >> 7) * 8;
    for (int L = blockIdx.x; L < ntv; L += gridDim.x) {
        const int it = (L & 7) * (ntv >> 3) + (L >> 3);
        const int row0 = (it >> 3) * 128, col0 = (it & 7) * 128, e = tile_expert(pend, row0);
        if (e < 0) continue;
        const int ce = cnt[e], lr0 = row0 - (__shfl(pend, e) - ((ce + 127) & ~127));
        gemm_tile128(x2b, 1024, rtok + e * 16384 + lr0, row0, W + (size_t)e * 1024 * 1024, 1024, col0, 1024, epi, sm, ce - lr0);
    }
}
__device__ void moe_down_naive(const Params& p, float* sm) {
    const int* cnt = (const int*)(p.ws + OFF_CNT);
    const bf16_t* H = (const bf16_t*)(p.ws + OFF_HEXP); const bf16_t* W = (const bf16_t*)(p.ws + OFF_WD);
    EpiBf16P epi{(bf16_t*)(p.ws + OFF_YEXP), 1024};
    const int pend = padded_end_lane(cnt);
    const int ntv = (__shfl(pend, 31) >> 7) * 8;
    for (int L = blockIdx.x; L < ntv; L += gridDim.x) {
        const int it = (L & 7) * (ntv >> 3) + (L >> 3);
        const int row0 = (it >> 3) * 128, col0 = (it & 7) * 128, e = tile_expert(pend, row0);
        if (e < 0) continue;
        gemm_tile128(H, 512, nullptr, row0, W + (size_t)e * 1024 * 512, 512, col0, 512, epi, sm);
    }
}
__device__ void final_ln(const Params& p) {
    const int* eid = (const int*)(p.ws + OFF_EID); const int* rank = (const int*)(p.ws + OFF_RANK); const float* gate = (const float*)(p.ws + OFF_GATE);
    const int* cnt = (const int*)(p.ws + OFF_CNT);
    const int pend = padded_end_lane(cnt);
    const int poffl = pend - (((threadIdx.x & 63) < 32 ? cnt[threadIdx.x & 31] : 0) + 127 & ~127);
    const bf16_t* Y = (const bf16_t*)(p.ws + OFF_YEXP);
    const bf16_t* x2b = (const bf16_t*)(p.ws + OFF_RB);
    const int lane = threadIdx.x & 63, wv = threadIdx.x >> 6;
    const int stride = gridDim.x * 4;
    for (int row = blockIdx.x * 4 + wv; row < T_; row += 2 * stride) {
        int rr[2]; rr[0] = row; rr[1] = row + stride < T_ ? row + stride : row;
        int2 ee[2], rk[2]; float2 gg2[2];
#pragma unroll
        for (int u = 0; u < 2; ++u) { ee[u] = *(const int2*)(eid + rr[u] * 2); rk[u] = *(const int2*)(rank + rr[u] * 2); gg2[u] = *(const float2*)(gate + rr[u] * 2); }
        uint2 xr[2][4], y0[2][4], y1[2][4];
#pragma unroll
        for (int u = 0; u < 2; ++u) {
            const int d0 = __shfl(poffl, ee[u].x) + rk[u].x, d1 = __shfl(poffl, ee[u].y) + rk[u].y;
#pragma unroll
            for (int i = 0; i < 4; ++i) {
                const int c = i * 256 + lane * 4;
                xr[u][i] = *(const uint2*)(x2b + (size_t)rr[u] * D_ + c); y0[u][i] = *(const uint2*)(Y + (size_t)d0 * D_ + c); y1[u][i] = *(const uint2*)(Y + (size_t)d1 * D_ + c);
            }
        }
#pragma unroll
        for (int u = 0; u < 2; ++u) {
            if (u == 1 && rr[1] == rr[0]) break;
            const float g0 = gg2[u].x, g1 = gg2[u].y;
            float4 a[4]; float s = 0.f;
#pragma unroll
            for (int i = 0; i < 4; ++i) {
                a[i].x = ALPHA * bf_lo(xr[u][i].x) + g0 * bf_lo(y0[u][i].x) + g1 * bf_lo(y1[u][i].x); a[i].y = ALPHA * bf_hi(xr[u][i].x) + g0 * bf_hi(y0[u][i].x) + g1 * bf_hi(y1[u][i].x);
                a[i].z = ALPHA * bf_lo(xr[u][i].y) + g0 * bf_lo(y0[u][i].y) + g1 * bf_lo(y1[u][i].y); a[i].w = ALPHA * bf_hi(xr[u][i].y) + g0 * bf_hi(y0[u][i].y) + g1 * bf_hi(y1[u][i].y);
                s += (a[i].x + a[i].y) + (a[i].z + a[i].w);
            }
            const float mu = wave_sum(s) * (1.0f / 1024.0f); float q = 0.f;
#pragma unroll
            for (int i = 0; i < 4; ++i) { a[i].x -= mu; a[i].y -= mu; a[i].z -= mu; a[i].w -= mu; q += (a[i].x * a[i].x + a[i].y * a[i].y) + (a[i].z * a[i].z + a[i].w * a[i].w); }
            const float rstd = rsqrtf(wave_sum(q) * (1.0f / 1024.0f) + LN_EPS);
#pragma unroll
            for (int i = 0; i < 4; ++i) {
                const int c = i * 256 + lane * 4; const float4 gg = *(const float4*)(p.ln_moe_g + c), bb = *(const float4*)(p.ln_moe_b + c);
                *(float4*)(p.out + (size_t)rr[u] * D_ + c) = make_float4(a[i].x * rstd * gg.x + bb.x, a[i].y * rstd * gg.y + bb.y, a[i].z * rstd * gg.z + bb.z, a[i].w * rstd * gg.w + bb.w);
            }
        }
    }
}

__device__ __forceinline__ void gemm1_phase(const Params& p, float* sm) {
    const bf16_t* A = (const bf16_t*)(p.ws + OFF_RB); const bf16_t* Bt = (const bf16_t*)(p.ws + OFF_WIN);
    EpiBf16P epi{(bf16_t*)(p.ws + OFF_HB), 3072};
    const int ntile = 128 * 24, nt8 = ntile >> 3;
    bool pre = false;
    for (int L = blockIdx.x; L < ntile; L += gridDim.x) {
        const int x = L & 7, q = L >> 3, patch = q >> 6, w = q & 63;
        const int mt = x * 16 + (patch / 3) * 8 + (w >> 3), nt = (patch % 3) * 8 + (w & 7);
        const int Ln = L + gridDim.x; int nmt = -1, nnt = 0;
        if (Ln < ntile) { const int q2 = Ln >> 3, p2 = q2 >> 6, w2 = q2 & 63; nmt = (Ln & 7) * 16 + (p2 / 3) * 8 + (w2 >> 3); nnt = (p2 % 3) * 8 + (w2 & 7); }
        gemm_tile128(A, 1024, nullptr, mt * 128, Bt, 1024, nt * 128, 1024, epi, sm, 128, pre, nmt < 0 ? -1 : nmt * 128, nnt * 128);
        pre = nmt >= 0;
#pragma unroll 1
        for (int j = 0; j < 4; ++j) expert_transpose_tile(p, L * 4 + j, sm + 8192);
    }
}

#define XB_TMO      128
#define XB_XCNT(j)  (256  + 64 * (j))
#define XB_XSUB(j)  (1280 + 64 * (j))
#define XB_XGEN(j)  (2304 + 64 * (j))
#define XB_TOP      3328
#define XB_TOPGEN   3392
#define XCD_BAR_WORDS 3456
#define XB_SPIN_CAP (1u << 18)
__device__ __forceinline__ unsigned xb_ld(unsigned* p)              { return __hip_atomic_load(p, __ATOMIC_RELAXED, __HIP_MEMORY_SCOPE_AGENT); }
__device__ __forceinline__ unsigned xb_add(unsigned* p, unsigned v) { return __hip_atomic_fetch_add(p, v, __ATOMIC_RELAXED, __HIP_MEMORY_SCOPE_AGENT); }
__device__ __forceinline__ unsigned xb_xcc_id() { return (unsigned)__builtin_amdgcn_s_getreg((3 << 11) | 20) & 0xFu; }
#define XB_SPIN(cond, bar) do { unsigned _sp = 0; while (cond) { __builtin_amdgcn_s_sleep(1); \
    if ((++_sp & 255u) == 0u) { if (xb_ld(&(bar)[XB_TMO])) break; if (_sp > XB_SPIN_CAP) { atomicAdd(&(bar)[XB_TMO], 1u); break; } } } } while (0)
struct XcdBarrier { unsigned* bar; unsigned x; volatile LAS unsigned* st; unsigned nloc, nx; };
__device__ __forceinline__ XcdBarrier xcd_barrier_post(unsigned* bar, volatile LAS unsigned* st) {
    XcdBarrier b; b.bar = bar; b.x = xb_xcc_id(); b.st = st; b.nloc = 0u; b.nx = 0u;
    if (threadIdx.x == 0) (void)xb_add(&bar[XB_XCNT(b.x)], 1u);
    return b;
}
__device__ __forceinline__ void xcd_barrier_complete(unsigned* bar, unsigned x, unsigned& nloc, unsigned& nx) {
    const unsigned G = gridDim.x * gridDim.y * gridDim.z;
    unsigned sum, cnt, mine, sp = 0u;
    for (;;) {
        sum = 0u; cnt = 0u; mine = 0u;
#pragma unroll
        for (unsigned j = 0; j < 16; ++j) { const unsigned c = xb_ld(&bar[XB_XCNT(j)]); sum += c; cnt += (c > 0u) ? 1u : 0u; mine = (j == x) ? c : mine; }
        if (sum == G) break;
        __builtin_amdgcn_s_sleep(1);
        if ((++sp & 255u) == 0u) { if (xb_ld(&bar[XB_TMO])) break; if (sp > XB_SPIN_CAP) { atomicAdd(&bar[XB_TMO], 1u); break; } }
    }
    nloc = mine > 0u ? mine : 1u; nx = cnt > 0u ? cnt : 1u;
}
__device__ __forceinline__ void xcd_barrier(XcdBarrier& b) {
    asm volatile("s_waitcnt vmcnt(0)" ::: "memory");
    __syncthreads();
    if (threadIdx.x == 0) {
        unsigned* bar = b.bar;
        __builtin_amdgcn_s_waitcnt(0);
        unsigned nloc = b.nloc, nx = b.nx;
        if (nloc == 0u) { xcd_barrier_complete(bar, b.x, nloc, nx); b.nloc = nloc; b.nx = nx; }
        const unsigned old = xb_add(&bar[XB_XSUB(b.x)], 1u);
        const unsigned gen = old / nloc;
        if (old + 1u == (gen + 1u) * nloc) {
            __builtin_amdgcn_fence(__ATOMIC_RELEASE, "agent");
            asm volatile("s_waitcnt vmcnt(0)" ::: "memory");
            const unsigned og = xb_add(&bar[XB_TOP], 1u);
            const unsigned tg = og / nx;
            if (og + 1u == (tg + 1u) * nx) xb_add(&bar[XB_TOPGEN], 1u);
            else XB_SPIN(xb_ld(&bar[XB_TOPGEN]) == tg, bar);
            __builtin_amdgcn_fence(__ATOMIC_ACQUIRE, "agent");
            xb_add(&bar[XB_XGEN(b.x)], 1u);
            asm volatile("s_waitcnt vmcnt(0)" ::: "memory");
        } else {
            XB_SPIN(xb_ld(&bar[XB_XGEN(b.x)]) == gen, bar);
            __builtin_amdgcn_fence(__ATOMIC_ACQUIRE, "agent");
            asm volatile("s_waitcnt vmcnt(0)" ::: "memory");
        }
    }
    __syncthreads();
}
constexpr size_t OFF_BAR = OFF_MISC + 768 * 1024;

__global__ void __launch_bounds__(256, 2) fwd_megakernel(Params p) {
    cg::grid_group grid = cg::this_grid();
    __shared__ __attribute__((aligned(16))) float sm[16384];
    unsigned char* ws = p.ws;
    if (ws == nullptr) grid.sync();
    XcdBarrier xb = xcd_barrier_post((unsigned*)(ws + OFF_BAR), nullptr);
    phase0(p, sm);
    xcd_barrier(xb);
    gemm1_phase(p, sm);
    gemm_phase_mfma((const bf16_t*)(ws + OFF_MEMB), 1024, (const bf16_t*)(ws + OFF_WXKV), 1024, 512, 2048, 1024, EpiBf16P{(bf16_t*)(ws + OFF_KVB), 2048}, sm);
    xcd_barrier(xb);
    ret_kv_mfma(p, sm);
    dil_mfma(p, sm);
    xcd_barrier(xb);
    ret_scan(p);
    if (blockIdx.x >= 256) deferred_prep(p, sm, blockIdx.x - 256, gridDim.x - 256);
    else if (gridDim.x <= 256) deferred_prep(p, sm, blockIdx.x, gridDim.x);
    xcd_barrier(xb);
    ret_out_mfma(p, sm);
    dil_merge(p);
    xcd_barrier(xb);
    gemm_phase_mfma((const bf16_t*)(ws + OFF_RB), 1024, (const bf16_t*)(ws + OFF_WOUT), 1024, T_, 1024, 1024, EpiV1{p.x, (bf16_t*)(ws + OFF_X1B), (float2*)(ws + OFF_ROPE)}, sm);
    xcd_barrier(xb);
    gemm_phase_mfma((const bf16_t*)(ws + OFF_X1B), 1024, (const bf16_t*)(ws + OFF_WXQ), 1024, T_, 1024, 1024,
                    EpiQ{(const float2*)(ws + OFF_ROPE), (const float*)(ws + OFF_G1), (bf16_t*)(ws + OFF_RB)}, sm);
    xcd_barrier(xb);
    xattn_mfma<1>(p, sm);
    xcd_barrier(xb);
    gemm_phase_mfma((const bf16_t*)(ws + OFF_OB), 1024, (const bf16_t*)(ws + OFF_WXO), 1024, T_, 1024, 1024, EpiXO{(const float2*)(ws + OFF_ROPE), (const bf16_t*)(ws + OFF_X1B), p.ln_mix_g, p.ln_mix_b, p.out}, sm);
    xcd_barrier(xb);
    route_tasks(p, p.out, sm);
    ln_pass<false>(p, p.out, p.ln_x_g, p.ln_x_b, nullptr, (bf16_t*)(ws + OFF_RB), sm);
    xcd_barrier(xb);
    moe_gu_naive(p, sm);
    xcd_barrier(xb);
    moe_down_naive(p, sm);
    xcd_barrier(xb);
    final_ln(p);
}

extern "C" void kernel_launch(void* const* d_in, const int* in_sizes, int n_in, void* d_out, int out_size, void* d_ws, size_t ws_size, hipStream_t stream) {
    static int grid_blocks = 0;
    if (!grid_blocks) {
        int dev = 0, cus = 0, per_cu = 0;
        (void)hipGetDevice(&dev);
        (void)hipDeviceGetAttribute(&cus, hipDeviceAttributeMultiprocessorCount, dev);
        (void)hipOccupancyMaxActiveBlocksPerMultiprocessor(&per_cu, fwd_megakernel, 256, 0);
        if (per_cu > 2) per_cu = 2;
        if (per_cu < 1) per_cu = 1;
        grid_blocks = cus * per_cu;
    }
    Params p{};
    p.x = (const float*)d_in[0]; p.mem = (const float*)d_in[1]; p.w_in = (const float*)d_in[2]; p.w_out = (const float*)d_in[3];
    p.ln_mix_g = (const float*)d_in[4]; p.ln_mix_b = (const float*)d_in[5]; p.w_xq = (const float*)d_in[6]; p.w_xkv = (const float*)d_in[7]; p.w_xo = (const float*)d_in[8];
    p.ln_x_g = (const float*)d_in[9]; p.ln_x_b = (const float*)d_in[10]; p.w_rg = (const float*)d_in[11]; p.w_re = (const float*)d_in[12];
    p.w_eg = (const float*)d_in[13]; p.w_eu = (const float*)d_in[14]; p.w_ed = (const float*)d_in[15]; p.ln_moe_g = (const float*)d_in[16]; p.ln_moe_b = (const float*)d_in[17];
    p.out = (float*)d_out; p.ws = (unsigned char*)d_ws;
    (void)hipMemsetAsync((unsigned char*)d_ws + OFF_BAR, 0, XCD_BAR_WORDS * 4, stream);
    void* args[] = {&p};
    hipError_t e = hipLaunchCooperativeKernel((void*)fwd_megakernel, dim3(grid_blocks), dim3(256), args, 0, stream);
    if (e != hipSuccess) fprintf(stderr, "cooperative launch failed: %s (grid %d)\n", hipGetErrorString(e), grid_blocks);
}
```

```cpp
#include <hip/hip_runtime.h>
#include <hip/hip_cooperative_groups.h>
#include <cstdio>
#include <cstdint>
namespace cg = cooperative_groups;

typedef unsigned short bf16_t;
typedef float f32x4 __attribute__((ext_vector_type(4)));
typedef unsigned u32x4 __attribute__((ext_vector_type(4)));

constexpr int T_ = 16384, D_ = 1024, S_ = 8192;
constexpr float ALPHA = 1.189207115002721f;
constexpr float LN_EPS = 1e-5f, GN_EPS = 1e-6f;
constexpr int NEXP = 32, RROWS = 32768 + 32 * 128;

constexpr size_t MiB = 1u << 20;
constexpr size_t OFF_WIN = 0, OFF_WOUT = 6 * MiB, OFF_WXQ = 8 * MiB, OFF_WXKV = 10 * MiB, OFF_WXO = 14 * MiB, OFF_WGU = 16 * MiB, OFF_WD = 80 * MiB;
constexpr size_t OFF_RB = 112 * MiB;
constexpr size_t OFF_KV = 144 * MiB;
constexpr size_t OFF_KVB = 160 * MiB;
constexpr size_t OFF_MEMB = 162 * MiB;
constexpr size_t OFF_ROPE = 163 * MiB;
constexpr size_t OFF_LSE = 165 * MiB;
constexpr size_t OFF_MISC = 167 * MiB;
constexpr size_t OFF_CNT = OFF_MISC;
constexpr size_t OFF_EID = OFF_MISC + 4096;
constexpr size_t OFF_GATE = OFF_EID + 131072;
constexpr size_t OFF_RANK = OFF_GATE + 131072;
constexpr size_t OFF_DEST = OFF_RANK + 131072;
constexpr size_t OFF_RTOK = OFF_DEST + 131072;
constexpr size_t OFF_RA = 168 * MiB;
constexpr size_t OFF_HB = OFF_RA;
constexpr size_t OFF_V1 = OFF_RA, OFF_X1B = OFF_RA + 64 * MiB;
constexpr size_t OFF_OB = OFF_RA, OFF_V2 = OFF_RA + 32 * MiB;
constexpr size_t OFF_HEXP = OFF_RA, OFF_YEXP = OFF_RA + 36 * MiB;

struct Params {
    const float *x, *mem, *w_in, *w_out, *ln_mix_g, *ln_mix_b, *w_xq, *w_xkv, *w_xo, *ln_x_g, *ln_x_b, *w_rg, *w_re, *w_eg, *w_eu, *w_ed, *ln_moe_g, *ln_moe_b;
    float* out;
    unsigned char* ws;
};

__device__ __forceinline__ float bf2f(bf16_t v) { return __uint_as_float(((unsigned)v) << 16); }
__device__ __forceinline__ float bf_lo(unsigned v) { return __uint_as_float(v << 16); }
__device__ __forceinline__ float bf_hi(unsigned v) { return __uint_as_float(v & 0xffff0000u); }
__device__ __forceinline__ unsigned f2bf(float f) { unsigned u = __float_as_uint(f); u += 0x7fffu + ((u >> 16) & 1u); return u >> 16; }
__device__ __forceinline__ unsigned pack2(float a, float b) { return f2bf(a) | (f2bf(b) << 16); }
__device__ __forceinline__ float wave_sum(float v) {
#pragma unroll
    for (int o = 32; o > 0; o >>= 1) v += __shfl_xor(v, o);
    return v;
}
__device__ __forceinline__ float wave_max(float v) {
#pragma unroll
    for (int o = 32; o > 0; o >>= 1) v = fmaxf(v, __shfl_xor(v, o));
    return v;
}
__device__ __forceinline__ float silu(float v) { return v / (1.0f + __expf(-v)); }

__device__ void transpose_tiles(const float* __restrict__ src, int K, int N, int nmat, bf16_t* __restrict__ dst, size_t dst_mat_stride, int mode, float* sm, const float* __restrict__ kscale = nullptr, int vb = -1, int nvb = 0) {
    if (vb < 0) { vb = blockIdx.x; nvb = gridDim.x; }
    float (*tile)[65] = (float (*)[65])sm;
    const int tk = K / 64, tn = N / 64, per = tk * tn, total = per * nmat, tid = threadIdx.x;
    for (int it = vb; it < total; it += nvb) {
        const int m = it / per, r = it % per, k0 = (r / tn) * 64, n0 = (r % tn) * 64;
        const float* s = src + (size_t)m * K * N;
        bf16_t* d = dst + (size_t)m * dst_mat_stride;
        __syncthreads();
#pragma unroll
        for (int i = 0; i < 4; ++i) {
            const int item = tid + 256 * i, k = item >> 4, n4 = (item & 15) * 4;
            const f32x4 v = __builtin_nontemporal_load((const f32x4*)(s + (size_t)(k0 + k) * N + n0 + n4)); const float sc = kscale ? kscale[k0 + k] : 1.0f;
            tile[k][n4] = v[0] * sc; tile[k][n4 + 1] = v[1] * sc; tile[k][n4 + 2] = v[2] * sc; tile[k][n4 + 3] = v[3] * sc;
        }
        __syncthreads();
#pragma unroll
        for (int i = 0; i < 2; ++i) {
            const int item = tid + 256 * i, kc = item & 7, n = item >> 3; int nn = n0 + n;
            if (mode == 1) nn = (nn >> 4) * 32 + (nn & 15); else if (mode == 2) nn = (nn >> 4) * 32 + 16 + (nn & 15);
            uint4 o;
            o.x = pack2(tile[kc * 8 + 0][n], tile[kc * 8 + 1][n]); o.y = pack2(tile[kc * 8 + 2][n], tile[kc * 8 + 3][n]);
            o.z = pack2(tile[kc * 8 + 4][n], tile[kc * 8 + 5][n]); o.w = pack2(tile[kc * 8 + 6][n], tile[kc * 8 + 7][n]);
            *(uint4*)(d + (size_t)nn * K + k0 + kc * 8) = o;
        }
    }
}


__device__ __forceinline__ void expert_transpose_tile(const Params& p, int q, float* sm) {
    float (*tile)[65] = (float (*)[65])sm;
    const int which = q >> 12, idx = q & 4095, m = idx >> 7, r = idx & 127, tid = threadIdx.x;
    const int K = which == 2 ? 512 : 1024, N = which == 2 ? 1024 : 512, tn = N / 64;
    const int k0 = (r / tn) * 64, n0 = (r % tn) * 64;
    const float* s = (which == 0 ? p.w_eg : (which == 1 ? p.w_eu : p.w_ed)) + (size_t)m * K * N;
    bf16_t* d = which == 2 ? (bf16_t*)(p.ws + OFF_WD) + (size_t)m * 1024 * 512 : (bf16_t*)(p.ws + OFF_WGU) + (size_t)m * 1024 * 1024;
    __syncthreads();
#pragma unroll
    for (int i = 0; i < 4; ++i) {
        const int item = tid + 256 * i, k = item >> 4, n4 = (item & 15) * 4;
        const f32x4 v = __builtin_nontemporal_load((const f32x4*)(s + (size_t)(k0 + k) * N + n0 + n4));
        tile[k][n4] = v[0]; tile[k][n4 + 1] = v[1]; tile[k][n4 + 2] = v[2]; tile[k][n4 + 3] = v[3];
    }
    __syncthreads();
#pragma unroll
    for (int i = 0; i < 2; ++i) {
        const int item = tid + 256 * i, kc = item & 7, n = item >> 3; int nn = n0 + n;
        if (which == 0) nn = (nn >> 5) * 64 + (nn & 31); else if (which == 1) nn = (nn >> 5) * 64 + 32 + (nn & 31);
        uint4 o;
        o.x = pack2(tile[kc * 8 + 0][n], tile[kc * 8 + 1][n]); o.y = pack2(tile[kc * 8 + 2][n], tile[kc * 8 + 3][n]);
        o.z = pack2(tile[kc * 8 + 4][n], tile[kc * 8 + 5][n]); o.w = pack2(tile[kc * 8 + 6][n], tile[kc * 8 + 7][n]);
        __builtin_nontemporal_store((u32x4){o.x, o.y, o.z, o.w}, (u32x4*)(d + (size_t)nn * K + k0 + kc * 8));
    }
}

__device__ void phase0(const Params& p, float* sm) {
    const int tid = threadIdx.x, nth = gridDim.x * 256, gtid = blockIdx.x * 256 + tid;
    {
        const float4* src = (const float4*)p.x; uint2* dst = (uint2*)(p.ws + OFF_RB);
        for (int i = gtid; i < T_ * D_ / 4; i += 4 * nth) {
            float4 v[4];
#pragma unroll
            for (int u = 0; u < 4; ++u) { const int j = i + u * nth; if (j < T_ * D_ / 4) { const f32x4 t_ = __builtin_nontemporal_load((const f32x4*)src + j); v[u] = make_float4(t_[0], t_[1], t_[2], t_[3]); } else v[u] = make_float4(0.f, 0.f, 0.f, 0.f); }
#pragma unroll
            for (int u = 0; u < 4; ++u) { const int j = i + u * nth; if (j < T_ * D_ / 4) { uint2 o; o.x = pack2(v[u].x, v[u].y); o.y = pack2(v[u].z, v[u].w); dst[j] = o; } }
        }
        const float4* src2 = (const float4*)p.mem; uint2* dst2 = (uint2*)(p.ws + OFF_MEMB);
        for (int i = gtid; i < 512 * D_ / 4; i += nth) { const float4 v = src2[i]; uint2 o; o.x = pack2(v.x, v.y); o.y = pack2(v.z, v.w); dst2[i] = o; }
    }
    {
        float2* rope = (float2*)(p.ws + OFF_ROPE);
        for (int i = gtid; i < 8192 * 32; i += nth) {
            const int pos = i >> 5, d = i & 31; double inv = 1.0;
            for (int q = 0; q < d; ++q) inv *= 0.7498942093324558;
            double rev = (double)pos * inv * 0.15915494309189535; rev -= floor(rev);
            const float rf = (float)rev;
            rope[i] = make_float2(__builtin_amdgcn_cosf(rf), __builtin_amdgcn_sinf(rf));
        }
        int* cnt = (int*)(p.ws + OFF_CNT);
        if (gtid < 32) cnt[gtid] = 0;
        int* rtok = (int*)(p.ws + OFF_RTOK);
        for (int i = gtid; i < RROWS; i += nth) rtok[i] = 0;
    }
    transpose_tiles(p.w_in, 1024, 3072, 1, (bf16_t*)(p.ws + OFF_WIN), 0, 0, sm);
    transpose_tiles(p.w_xkv, 1024, 2048, 1, (bf16_t*)(p.ws + OFF_WXKV), 0, 0, sm);
}

template <class Epi>
__device__ __forceinline__ void gemm_tile64(const bf16_t* __restrict__ A, int lda, const int* __restrict__ rowidx, int row0,
                                            const bf16_t* __restrict__ Bt, int ldb, int col0, int K, const Epi& epi, float* sm) {
    float (*As)[68] = (float (*)[68])sm;
    float (*Bs)[68] = (float (*)[68])(sm + 16 * 68);
    const int tid = threadIdx.x, tx = tid & 15, ty = tid >> 4, lr = tid >> 2, lk = (tid & 3) * 4;
    const int arow = rowidx ? rowidx[row0 + lr] : row0 + lr;
    const bf16_t* ap = A + (size_t)arow * lda + lk;
    const bf16_t* bp = Bt + (size_t)(col0 + lr) * ldb + lk;
    float acc[4][4];
#pragma unroll
    for (int i = 0; i < 4; ++i)
#pragma unroll
        for (int j = 0; j < 4; ++j) acc[i][j] = 0.f;
    for (int k0 = 0; k0 < K; k0 += 16) {
        const uint2 av = *(const uint2*)(ap + k0), bv = *(const uint2*)(bp + k0);
        __syncthreads();
        As[lk + 0][lr] = bf_lo(av.x); As[lk + 1][lr] = bf_hi(av.x); As[lk + 2][lr] = bf_lo(av.y); As[lk + 3][lr] = bf_hi(av.y);
        Bs[lk + 0][lr] = bf_lo(bv.x); Bs[lk + 1][lr] = bf_hi(bv.x); Bs[lk + 2][lr] = bf_lo(bv.y); Bs[lk + 3][lr] = bf_hi(bv.y);
        __syncthreads();
#pragma unroll
        for (int k = 0; k < 16; ++k) {
            const float4 a = *(const float4*)&As[k][ty * 4], b = *(const float4*)&Bs[k][tx * 4];
            const float aa[4] = {a.x, a.y, a.z, a.w}, bb[4] = {b.x, b.y, b.z, b.w};
#pragma unroll
            for (int i = 0; i < 4; ++i)
#pragma unroll
                for (int j = 0; j < 4; ++j) acc[i][j] += aa[i] * bb[j];
        }
    }
#pragma unroll
    for (int i = 0; i < 4; ++i) epi(row0 + ty * 4 + i, col0 + tx * 4, (f32x4){acc[i][0], acc[i][1], acc[i][2], acc[i][3]});
}

struct EpiBf16 {
    static constexpr bool PAIRED = false, WHOLE = false, PERM = false;
    bf16_t* O; int ldc;
    __device__ __forceinline__ void operator()(int row, int col, f32x4 v) const { uint2 o; o.x = pack2(v[0], v[1]); o.y = pack2(v[2], v[3]); *(uint2*)(O + (size_t)row * ldc + col) = o; }
};
struct EpiBf16P {
    static constexpr bool PAIRED = false, WHOLE = false, PERM = true, GU8 = false;
    bf16_t* O; int ldc;
    __device__ __forceinline__ void oct(int row, int col, f32x4 v0, f32x4 v1) const {
        uint4 o; o.x = pack2(v0[0], v0[1]); o.y = pack2(v0[2], v0[3]); o.z = pack2(v1[0], v1[1]); o.w = pack2(v1[2], v1[3]);
        *(uint4*)(O + (size_t)row * ldc + col) = o;
    }
};
struct EpiGU8 {
    static constexpr bool PAIRED = false, WHOLE = false, PERM = true, GU8 = true;
    bf16_t* H;
    __device__ __forceinline__ void gu8(int row, int ff, f32x4 g0, f32x4 g1, f32x4 u0, f32x4 u1) const {
        uint4 o;
        o.x = pack2(silu(g0[0]) * u0[0], silu(g0[1]) * u0[1]); o.y = pack2(silu(g0[2]) * u0[2], silu(g0[3]) * u0[3]);
        o.z = pack2(silu(g1[0]) * u1[0], silu(g1[1]) * u1[1]); o.w = pack2(silu(g1[2]) * u1[2], silu(g1[3]) * u1[3]);
        *(uint4*)(H + (size_t)row * 512 + ff) = o;
    }
};
struct EpiResid {
    static constexpr bool PAIRED = false, WHOLE = false, PERM = false;
    const float* R; float* O;
    __device__ __forceinline__ void operator()(int row, int col, f32x4 v) const {
        const float4 r = *(const float4*)(R + (size_t)row * D_ + col);
        *(float4*)(O + (size_t)row * D_ + col) = make_float4(ALPHA * r.x + v[0], ALPHA * r.y + v[1], ALPHA * r.z + v[2], ALPHA * r.w + v[3]);
    }
};
struct EpiResidBf {
    static constexpr bool PAIRED = false, WHOLE = false, PERM = false;
    const bf16_t* R; float* O;
    __device__ __forceinline__ void operator()(int row, int col, f32x4 v) const {
        const uint2 r = *(const uint2*)(R + (size_t)row * D_ + col);
        *(float4*)(O + (size_t)row * D_ + col) = make_float4(ALPHA * bf_lo(r.x) + v[0], ALPHA * bf_hi(r.x) + v[1], ALPHA * bf_lo(r.y) + v[2], ALPHA * bf_hi(r.y) + v[3]);
    }
};
struct EpiGU {
    static constexpr bool PAIRED = true, WHOLE = false, PERM = false;
    bf16_t* H;
    __device__ __forceinline__ void pair(int row, int col, f32x4 g, f32x4 u) const {
        const int ff = (col >> 5) * 16 + (col & 15);
        uint2 o; o.x = pack2(silu(g[0]) * u[0], silu(g[1]) * u[1]); o.y = pack2(silu(g[2]) * u[2], silu(g[3]) * u[3]);
        *(uint2*)(H + (size_t)row * 512 + ff) = o;
    }
    __device__ __forceinline__ void operator()(int row, int col, f32x4 v) const {
        f32x4 u; u[0] = __shfl_xor(v[0], 4); u[1] = __shfl_xor(v[1], 4); u[2] = __shfl_xor(v[2], 4); u[3] = __shfl_xor(v[3], 4);
        if ((col & 16) == 0) {
            const int ff = (col >> 5) * 16 + (col & 15);
            uint2 o; o.x = pack2(silu(v[0]) * u[0], silu(v[1]) * u[1]); o.y = pack2(silu(v[2]) * u[2], silu(v[3]) * u[3]);
            *(uint2*)(H + (size_t)row * 512 + ff) = o;
        }
    }
};

template <class Epi>
__device__ void gemm_phase_naive(const bf16_t* A, int lda, const bf16_t* Bt, int ldb, int M, int N, int K, const Epi& epi, float* sm) {
    const int tm = M / 64, tn = N / 64;
    for (int it = blockIdx.x; it < tm * tn; it += gridDim.x) gemm_tile64(A, lda, nullptr, (it / tn) * 64, Bt, ldb, (it % tn) * 64, K, epi, sm);
}


#define LAS __attribute__((address_space(3)))
typedef short bf16x8 __attribute__((ext_vector_type(8)));
template <class Epi>
__device__ __forceinline__ void gemm_tile128(const bf16_t* __restrict__ A, int lda, const int* __restrict__ rowidx, int row0,
                                             const bf16_t* __restrict__ Bt, int ldb, int col0, int K, const Epi& epi, float* sm, int nvalid = 128,
                                             bool pre = false, int nrow0 = -1, int ncol0 = 0) {
    LAS unsigned char* lds = (LAS unsigned char*)sm;
    const int tid = threadIdx.x, wid = __builtin_amdgcn_readfirstlane(tid >> 6), lane = tid & 63, wr = wid >> 1, wc = wid & 1, fr = lane & 15, fq = lane >> 4;
    const int r0 = tid >> 3, c8 = ((tid & 7) ^ ((tid >> 4) & 7)) * 8;
    const bf16_t* ap[4]; const bf16_t* bp[4];
#pragma unroll
    for (int i = 0; i < 4; ++i) {
        const int ar = rowidx ? ((r0 + i * 32 < nvalid) ? rowidx[r0 + i * 32] : 0) : row0 + r0 + i * 32;
        int br = r0 + i * 32;
        if constexpr (Epi::PERM) { const int q = br & 31; br = (br & ~31) + 8 * ((q & 15) >> 2) + 4 * (q >> 4) + (q & 3); }
        ap[i] = A + (size_t)ar * lda + c8; bp[i] = Bt + (size_t)(col0 + br) * ldb + c8;
    }
    const int g = (fr >> 1) & 7, sw0 = (fq ^ g) * 16, sw1 = ((fq ^ g) ^ 4) * 16;
    const int arow = (wr * 64 + fr) * 128, brow = 16384 + (wc * 64 + fr) * 128;
    f32x4 acc[4][4];
#pragma unroll
    for (int m = 0; m < 4; ++m)
#pragma unroll
        for (int n = 0; n < 4; ++n) acc[m][n] = (f32x4){0.f, 0.f, 0.f, 0.f};
#define GT_ISSUE(kt) do { const int st_ = ((kt) & 1) * 32768 + wid * 1024; _Pragma("unroll") for (int i = 0; i < 4; ++i) { \
        __builtin_amdgcn_global_load_lds((const unsigned*)(ap[i] + (kt) * 64), (LAS unsigned*)(lds + st_ + i * 4096), 16, 0, 0); \
        __builtin_amdgcn_global_load_lds((const unsigned*)(bp[i] + (kt) * 64), (LAS unsigned*)(lds + st_ + 16384 + i * 4096), 16, 0, 0); } } while (0)
    const int nk = K >> 6;
    const long dA = (long)(nrow0 - row0) * lda, dB = (long)(ncol0 - col0) * ldb;
    if (!pre) {
        __syncthreads();
        GT_ISSUE(0);
    }
    for (int kt = 0; kt < nk; ++kt) {
        asm volatile("s_waitcnt vmcnt(0) lgkmcnt(0)\n\ts_barrier" ::: "memory");
        if (kt + 1 < nk) GT_ISSUE(kt + 1);
        else if (nrow0 >= 0) {
#pragma unroll
            for (int i = 0; i < 4; ++i) {
                __builtin_amdgcn_global_load_lds((const unsigned*)(ap[i] + dA), (LAS unsigned*)(lds + wid * 1024 + i * 4096), 16, 0, 0);
                __builtin_amdgcn_global_load_lds((const unsigned*)(bp[i] + dB), (LAS unsigned*)(lds + wid * 1024 + 16384 + i * 4096), 16, 0, 0);
            }
        }
        const LAS unsigned char* sb = lds + (kt & 1) * 32768;
#pragma unroll
        for (int kh = 0; kh < 2; ++kh) {
            const int sw = kh ? sw1 : sw0;
            bf16x8 At[4], Bf[4];
#pragma unroll
            for (int m = 0; m < 4; ++m) At[m] = *(const LAS bf16x8*)(sb + arow + sw + m * 2048);
#pragma unroll
            for (int n = 0; n < 4; ++n) Bf[n] = *(const LAS bf16x8*)(sb + brow + sw + n * 2048);
#pragma unroll
            for (int m = 0; m < 4; ++m)
#pragma unroll
                for (int n = 0; n < 4; ++n) acc[m][n] = __builtin_amdgcn_mfma_f32_16x16x32_bf16(Bf[n], At[m], acc[m][n], 0, 0, 0);
        }
    }
#undef GT_ISSUE
    if constexpr (Epi::WHOLE) { epi.tile(acc, row0, col0, wr, wc, fr, fq); }
    else if constexpr (Epi::PERM) {
        if constexpr (Epi::GU8) {
#pragma unroll
            for (int m = 0; m < 4; ++m) epi.gu8(row0 + wr * 64 + m * 16 + fr, ((col0 + wc * 64) >> 6) * 32 + 8 * fq, acc[m][0], acc[m][1], acc[m][2], acc[m][3]);
        } else {
#pragma unroll
            for (int m = 0; m < 4; ++m)
#pragma unroll
                for (int n = 0; n < 4; n += 2) epi.oct(row0 + wr * 64 + m * 16 + fr, col0 + wc * 64 + (n >> 1) * 32 + 8 * fq, acc[m][n], acc[m][n + 1]);
        }
    }
    else {
#pragma unroll
    for (int m = 0; m < 4; ++m) {
        const int row = row0 + wr * 64 + m * 16 + fr;
        if constexpr (Epi::PAIRED) {
#pragma unroll
            for (int n = 0; n < 4; n += 2) epi.pair(row, col0 + wc * 64 + n * 16 + fq * 4, acc[m][n], acc[m][n + 1]);
        } else {
#pragma unroll
            for (int n = 0; n < 4; ++n) epi(row, col0 + wc * 64 + n * 16 + fq * 4, acc[m][n]);
        }
    }
    }
}

constexpr size_t OFF_G1 = OFF_MISC + 1010 * 1024;
__device__ __forceinline__ void row_stats(const float2* __restrict__ P, int row, int fq, float& mu, float& rstd) {
    const float2* ps = P + (size_t)row * 16 + fq * 4;
    const float2 a = ps[0], b = ps[1], c = ps[2], d = ps[3];
    float s1 = (a.x + b.x) + (c.x + d.x), s2 = (a.y + b.y) + (c.y + d.y);
    s1 += __shfl_xor(s1, 16); s1 += __shfl_xor(s1, 32); s2 += __shfl_xor(s2, 16); s2 += __shfl_xor(s2, 32);
    mu = s1 * (1.0f / 1024.0f); rstd = rsqrtf(s2 * (1.0f / 1024.0f) - mu * mu + LN_EPS);
}
struct EpiV1 {
    static constexpr bool PAIRED = false, WHOLE = true, PERM = true;
    const float* X; bf16_t* O; float2* P;
    __device__ __forceinline__ void tile(f32x4 (&acc)[4][4], int row0, int col0, int wr, int wc, int fr, int fq) const {
        const int slot = (col0 >> 7) * 2 + wc, rbase = row0 + wr * 64 + fr, cb = col0 + wc * 64 + 8 * fq;
#pragma unroll
        for (int m = 0; m < 4; ++m) {
            float s1 = 0.f, s2 = 0.f; const size_t ro = (size_t)(rbase + m * 16) * D_;
#pragma unroll
            for (int np = 0; np < 2; ++np) {
                const int c = cb + np * 32;
                const float4 xa = *(const float4*)(X + ro + c), xb = *(const float4*)(X + ro + c + 4);
                const f32x4 a = acc[m][2 * np], b = acc[m][2 * np + 1];
                const float v0 = a[0] + ALPHA * xa.x, v1 = a[1] + ALPHA * xa.y, v2 = a[2] + ALPHA * xa.z, v3 = a[3] + ALPHA * xa.w;
                const float v4 = b[0] + ALPHA * xb.x, v5 = b[1] + ALPHA * xb.y, v6 = b[2] + ALPHA * xb.z, v7 = b[3] + ALPHA * xb.w;
                s1 += ((v0 + v1) + (v2 + v3)) + ((v4 + v5) + (v6 + v7));
                s2 += ((v0 * v0 + v1 * v1) + (v2 * v2 + v3 * v3)) + ((v4 * v4 + v5 * v5) + (v6 * v6 + v7 * v7));
                uint4 o; o.x = pack2(v0, v1); o.y = pack2(v2, v3); o.z = pack2(v4, v5); o.w = pack2(v6, v7); *(uint4*)(O + ro + c) = o;
            }
            s1 += __shfl_xor(s1, 16); s1 += __shfl_xor(s1, 32); s2 += __shfl_xor(s2, 16); s2 += __shfl_xor(s2, 32);
            if (fq == 0) P[(size_t)(rbase + m * 16) * 16 + slot] = make_float2(s1, s2);
        }
    }
};

struct EpiQ {
    static constexpr bool PAIRED = false, WHOLE = true, PERM = true;
    const float2* P; const float* GB; bf16_t* O;
    __device__ __forceinline__ void tile(f32x4 (&acc)[4][4], int row0, int col0, int wr, int wc, int fr, int fq) const {
        const int rbase = row0 + wr * 64 + fr, cb = col0 + wc * 64 + 8 * fq;
#pragma unroll
        for (int m = 0; m < 4; ++m) {
            float mu, rstd; row_stats(P, rbase + m * 16, fq, mu, rstd);
#pragma unroll
            for (int np = 0; np < 2; ++np) {
                const int c = cb + np * 32;
                const float4 g0 = *(const float4*)(GB + c), g1 = *(const float4*)(GB + c + 4), b0 = *(const float4*)(GB + 1024 + c), b1 = *(const float4*)(GB + 1024 + c + 4);
                const f32x4 a = acc[m][2 * np], b = acc[m][2 * np + 1];
                uint4 o;
                o.x = pack2(rstd * (a[0] - mu * g0.x) + b0.x, rstd * (a[1] - mu * g0.y) + b0.y);
                o.y = pack2(rstd * (a[2] - mu * g0.z) + b0.z, rstd * (a[3] - mu * g0.w) + b0.w);
                o.z = pack2(rstd * (b[0] - mu * g1.x) + b1.x, rstd * (b[1] - mu * g1.y) + b1.y);
                o.w = pack2(rstd * (b[2] - mu * g1.z) + b1.z, rstd * (b[3] - mu * g1.w) + b1.w);
                *(uint4*)(O + (size_t)(rbase + m * 16) * D_ + c) = o;
            }
        }
    }
};

struct EpiXO {
    static constexpr bool PAIRED = false, WHOLE = true, PERM = true;
    const float2* P; const bf16_t* V; const float* G; const float* Bv; float* O;
    __device__ __forceinline__ void tile(f32x4 (&acc)[4][4], int row0, int col0, int wr, int wc, int fr, int fq) const {
        const int rbase = row0 + wr * 64 + fr, cb = col0 + wc * 64 + 8 * fq;
#pragma unroll
        for (int m = 0; m < 4; ++m) {
            float mu, rstd; row_stats(P, rbase + m * 16, fq, mu, rstd);
            const size_t ro = (size_t)(rbase + m * 16) * D_;
#pragma unroll
            for (int np = 0; np < 2; ++np) {
                const int c = cb + np * 32;
                const float4 g0 = *(const float4*)(G + c), g1 = *(const float4*)(G + c + 4), b0 = *(const float4*)(Bv + c), b1 = *(const float4*)(Bv + c + 4);
                const uint4 v = *(const uint4*)(V + ro + c);
                const f32x4 a = acc[m][2 * np], b = acc[m][2 * np + 1];
                *(float4*)(O + ro + c) = make_float4(ALPHA * ((bf_lo(v.x) - mu) * rstd * g0.x + b0.x) + a[0], ALPHA * ((bf_hi(v.x) - mu) * rstd * g0.y + b0.y) + a[1],
                                                     ALPHA * ((bf_lo(v.y) - mu) * rstd * g0.z + b0.z) + a[2], ALPHA * ((bf_hi(v.y) - mu) * rstd * g0.w + b0.w) + a[3]);
                *(float4*)(O + ro + c + 4) = make_float4(ALPHA * ((bf_lo(v.z) - mu) * rstd * g1.x + b1.x) + b[0], ALPHA * ((bf_hi(v.z) - mu) * rstd * g1.y + b1.y) + b[1],
                                                         ALPHA * ((bf_lo(v.w) - mu) * rstd * g1.z + b1.z) + b[2], ALPHA * ((bf_hi(v.w) - mu) * rstd * g1.w + b1.w) + b[3]);
            }
        }
    }
};


template <class Epi>
__device__ __forceinline__ void gemm_phase_mfma(const bf16_t* A, int lda, const bf16_t* Bt, int ldb, int M, int N, int K, const Epi& epi, float* sm) {
    const int tm = M / 128, tn = N / 128;
    const int nt8 = (tm * tn) >> 3;
    for (int L = blockIdx.x; L < tm * tn; L += gridDim.x) { const int it = (L & 7) * nt8 + (L >> 3); gemm_tile128(A, lda, nullptr, (it / tn) * 128, Bt, ldb, (it % tn) * 128, K, epi, sm); }
}

typedef short v4i16_t __attribute__((ext_vector_type(4)));
typedef unsigned u32x2 __attribute__((ext_vector_type(2)));
__device__ __forceinline__ v4i16_t tr_read(const LAS unsigned char* a) { return __builtin_amdgcn_ds_read_tr16_b64_v4i16((LAS v4i16_t*)a); }
__device__ __forceinline__ bf16x8 cat8(v4i16_t lo, v4i16_t hi) { return (bf16x8){lo[0], lo[1], lo[2], lo[3], hi[0], hi[1], hi[2], hi[3]}; }
__device__ __forceinline__ bf16x8 pack8(f32x4 a, f32x4 b) {
    union { unsigned u[4]; bf16x8 v; } r;
    r.u[0] = pack2(a[0], a[1]); r.u[1] = pack2(a[2], a[3]); r.u[2] = pack2(b[0], b[1]); r.u[3] = pack2(b[2], b[3]);
    return r.v;
}

__device__ __constant__ float LOG2G[4] = {-0.04580368961312479f, -0.02272007650008353f, -0.011315313227834146f, -0.005646563141142063f};

__device__ void ret_kv_naive(const Params& p, float* sm) {
    const bf16_t* hb = (const bf16_t*)(p.ws + OFF_HB);
    const float2* rope = (const float2*)(p.ws + OFF_ROPE);
    float* KV = (float*)(p.ws + OFF_KV);
    float (*ks)[64] = (float (*)[64])sm;
    const int tid = threadIdx.x;
    for (int it = blockIdx.x; it < 512; it += gridDim.x) {
        const int b = it >> 8, h = (it >> 6) & 3, n = it & 63;
        const int t0 = b * S_ + n * 128;
        __syncthreads();
        for (int i = tid; i < 128 * 32; i += 256) {
            const int j = i >> 5, d = i & 31;
            const bf16_t* kr = hb + (size_t)(t0 + j) * 3072 + 256 + h * 64;
            const float k1 = bf2f(kr[d]), k2 = bf2f(kr[d + 32]);
            const float2 cs = rope[(n * 128 + j) * 32 + d];
            const float z = 0.125f * exp2f(LOG2G[h] * (float)(127 - j));
            ks[j][d] = (k1 * cs.x - k2 * cs.y) * z; ks[j][d + 32] = (k1 * cs.y + k2 * cs.x) * z;
        }
        __syncthreads();
        const int e = tid & 127, d0 = (tid >> 7) * 32;
        float acc[32];
#pragma unroll
        for (int i = 0; i < 32; ++i) acc[i] = 0.f;
        for (int j = 0; j < 128; ++j) {
            const float vj = bf2f(hb[(size_t)(t0 + j) * 3072 + 512 + h * 128 + e]);
#pragma unroll
            for (int i = 0; i < 32; ++i) acc[i] += ks[j][d0 + i] * vj;
        }
        float* o = KV + (size_t)it * 8192;
#pragma unroll
        for (int i = 0; i < 32; ++i) o[(d0 + i) * 128 + e] = acc[i];
    }
}
__device__ void ret_scan(const Params& p) {
    float* KV = (float*)(p.ws + OFF_KV);
    for (int g = blockIdx.x * 256 + threadIdx.x; g < 8 * 8192; g += gridDim.x * 256) {
        const int bh = g >> 13, idx = g & 8191, h = bh & 3;
        const float gc = exp2f(LOG2G[h] * 128.0f);
        float* q = KV + (size_t)bh * 64 * 8192 + idx;
        bf16_t* sb = (bf16_t*)((unsigned char*)p.out + 48 * MiB) + (size_t)bh * 64 * 8192 + idx;
        float kv[64];
#pragma unroll
        for (int n = 0; n < 64; ++n) kv[n] = q[(size_t)n * 8192];
        float st = 0.f;
#pragma unroll
        for (int n = 0; n < 64; ++n) { q[(size_t)n * 8192] = st; sb[(size_t)n * 8192] = (bf16_t)f2bf(st); st = gc * st + kv[n]; }
    }
}
__device__ void ret_out_naive(const Params& p, float* sm) {
    const bf16_t* hb = (const bf16_t*)(p.ws + OFF_HB);
    const float2* rope = (const float2*)(p.ws + OFF_ROPE);
    const float* KV = (const float*)(p.ws + OFF_KV);
    bf16_t* y = (bf16_t*)(p.ws + OFF_RB);
    float* qs = sm; float* ss = sm + 64; float* red = sm + 192;
    const int tid = threadIdx.x;
    for (int it = blockIdx.x; it < T_ * 4; it += gridDim.x) {
        const int t = it >> 2, h = it & 3, b = t >> 13, pos = t & 8191, n = pos >> 7, i = pos & 127;
        __syncthreads();
        if (tid < 32) {
            const bf16_t* qr = hb + (size_t)t * 3072 + h * 64;
            const float q1 = bf2f(qr[tid]), q2 = bf2f(qr[tid + 32]); const float2 cs = rope[pos * 32 + tid];
            qs[tid] = q1 * cs.x - q2 * cs.y; qs[tid + 32] = q1 * cs.y + q2 * cs.x;
        }
        __syncthreads();
        if (tid < 128) {
            const int j = tid; float s = 0.f;
            if (j <= i) {
                const int tj = t - i + j, pj = pos - i + j;
                const bf16_t* kr = hb + (size_t)tj * 3072 + 256 + h * 64;
                for (int d = 0; d < 32; ++d) {
                    const float k1 = bf2f(kr[d]), k2 = bf2f(kr[d + 32]); const float2 cs = rope[pj * 32 + d];
                    s += qs[d] * (k1 * cs.x - k2 * cs.y) + qs[d + 32] * (k1 * cs.y + k2 * cs.x);
                }
                s *= 0.125f * exp2f(LOG2G[h] * (float)(i - j));
            }
            ss[j] = s;
        }
        __syncthreads();
        float yv = 0.f;
        if (tid < 128) {
            const int e = tid;
            for (int j = 0; j <= i; ++j) yv += ss[j] * bf2f(hb[(size_t)(t - i + j) * 3072 + 512 + h * 128 + e]);
            const float* st = KV + ((size_t)((b * 4 + h) * 64 + n)) * 8192;
            float c = 0.f;
            for (int d = 0; d < 64; ++d) c += qs[d] * st[d * 128 + e];
            yv += c * exp2f(LOG2G[h] * (float)(i + 1));
        }
        float s1 = wave_sum(tid < 128 ? yv : 0.f);
        if ((tid & 63) == 0) red[tid >> 6] = s1;
        __syncthreads();
        const float mu = (red[0] + red[1]) * (1.0f / 128.0f);
        const float dv = yv - mu;
        float s2 = wave_sum(tid < 128 ? dv * dv : 0.f);
        if ((tid & 63) == 0) red[4 + (tid >> 6)] = s2;
        __syncthreads();
        const float var = (red[4] + red[5]) * (1.0f / 128.0f);
        if (tid < 128) {
            const float g = bf2f(hb[(size_t)t * 3072 + 1024 + h * 128 + tid]);
            y[(size_t)t * 1024 + h * 128 + tid] = (bf16_t)f2bf(silu(g) * dv * rsqrtf(var + GN_EPS));
        }
    }
}


constexpr size_t OFF_SB_IN_OUT = 48 * MiB;
__device__ __forceinline__ void rot8(const u32x4 lo, const u32x4 hi, const float2* __restrict__ rp, float z, u32x4& olo, u32x4& ohi) {
    float a[8], b[8];
#pragma unroll
    for (int i = 0; i < 4; ++i) { a[2 * i] = bf_lo(lo[i]); a[2 * i + 1] = bf_hi(lo[i]); b[2 * i] = bf_lo(hi[i]); b[2 * i + 1] = bf_hi(hi[i]); }
    float ra[8], rb[8];
#pragma unroll
    for (int i = 0; i < 8; ++i) { const float2 cs = rp[i]; ra[i] = (a[i] * cs.x - b[i] * cs.y) * z; rb[i] = (a[i] * cs.y + b[i] * cs.x) * z; }
#pragma unroll
    for (int i = 0; i < 4; ++i) { olo[i] = pack2(ra[2 * i], ra[2 * i + 1]); ohi[i] = pack2(rb[2 * i], rb[2 * i + 1]); }
}
__device__ void ret_kv_mfma(const Params& p, float* sm) {
    LAS unsigned char* lds = (LAS unsigned char*)sm;
    const bf16_t* hb = (const bf16_t*)(p.ws + OFF_HB);
    const float2* rope = (const float2*)(p.ws + OFF_ROPE);
    float* KV = (float*)(p.ws + OFF_KV);
    const int tid = threadIdx.x, wid = __builtin_amdgcn_readfirstlane(tid >> 6), lane = tid & 63, fr = lane & 15, fq = lane >> 4;
    for (int L = blockIdx.x; L < 1024; L += gridDim.x) {
        const int it = (L & 7) * 128 + (L >> 3);
        const int eh = it & 1, it3 = it >> 1, b = it3 >> 8, h = (it3 >> 6) & 3, n = it3 & 63;
        const int t0 = b * S_ + n * 128;
        __syncthreads();
#pragma unroll
        for (int i = 0; i < 2; ++i) {
            const int item = tid + 256 * i, j = item >> 2, c = item & 3;
            const bf16_t* kr = hb + (size_t)(t0 + j) * 3072 + 256 + h * 64 + 8 * c;
            const u32x4 lo = *(const u32x4*)kr, hi = *(const u32x4*)(kr + 32);
            u32x4 olo, ohi;
            rot8(lo, hi, rope + (size_t)(n * 128 + j) * 32 + 8 * c, 0.125f * exp2f(LOG2G[h] * (float)(127 - j)), olo, ohi);
            *(LAS u32x4*)(lds + j * 160 + c * 16) = olo; *(LAS u32x4*)(lds + j * 160 + 64 + c * 16) = ohi;
        }
#pragma unroll
        for (int i = 0; i < 4; ++i) {
            const int item = tid + 256 * i, j = item >> 3, ch = item & 7;
            *(LAS u32x4*)(lds + 20480 + j * 160 + ch * 16) = *(const u32x4*)(hb + (size_t)(t0 + j) * 3072 + 512 + h * 128 + eh * 64 + ch * 8);
        }
        __syncthreads();
        f32x4 acc[4];
#pragma unroll
        for (int dt = 0; dt < 4; ++dt) acc[dt] = (f32x4){0.f, 0.f, 0.f, 0.f};
#pragma unroll
        for (int ks = 0; ks < 4; ++ks) {
            const int rowoff = (32 * ks + 4 * fq + (fr >> 2)) * 160 + 8 * (fr & 3);
            const LAS unsigned char* ax = lds + 20480 + rowoff + 32 * wid;
            const bf16x8 xf = cat8(tr_read(ax), tr_read(ax + 16 * 160));
#pragma unroll
            for (int dt = 0; dt < 4; ++dt) {
                const LAS unsigned char* ay = lds + rowoff + 32 * dt;
                const bf16x8 yf = cat8(tr_read(ay), tr_read(ay + 16 * 160));
                acc[dt] = __builtin_amdgcn_mfma_f32_16x16x32_bf16(xf, yf, acc[dt], 0, 0, 0);
            }
        }
        float* o = KV + (size_t)it3 * 8192;
#pragma unroll
        for (int dt = 0; dt < 4; ++dt) *(f32x4*)(o + (16 * dt + fr) * 128 + eh * 64 + 16 * wid + 4 * fq) = acc[dt];
    }
}
__device__ void ret_out_mfma(const Params& p, float* sm) {
    LAS unsigned char* lds = (LAS unsigned char*)sm;
    const bf16_t* hb = (const bf16_t*)(p.ws + OFF_HB);
    const float2* rope = (const float2*)(p.ws + OFF_ROPE);
    const bf16_t* SB = (const bf16_t*)((const unsigned char*)p.out + OFF_SB_IN_OUT);
    bf16_t* y = (bf16_t*)(p.ws + OFF_RB);
    const int tid = threadIdx.x, wid = __builtin_amdgcn_readfirstlane(tid >> 6), lane = tid & 63, fr = lane & 15, fq = lane >> 4;
    for (int L = blockIdx.x; L < 1024; L += gridDim.x) {
        const int it = (L & 7) * 128 + (L >> 3);
        const int half = it & 1, it3 = it >> 1, b = it3 >> 8, h = (it3 >> 6) & 3, n = it3 & 63;
        const int t0 = b * S_ + n * 128;
        const int qt = (wid & 1) ? (8 - wid - half) : (wid + half);
        const float lg2 = LOG2G[h];
        __syncthreads();
#pragma unroll
        for (int i = 0; i < 2; ++i) {
            const int item = tid + 256 * i, j = item >> 2, c = item & 3;
            const bf16_t* kr = hb + (size_t)(t0 + j) * 3072 + 256 + h * 64 + 8 * c;
            const u32x4 lo = *(const u32x4*)kr, hi = *(const u32x4*)(kr + 32);
            u32x4 olo, ohi;
            rot8(lo, hi, rope + (size_t)(n * 128 + j) * 32 + 8 * c, 0.125f, olo, ohi);
            *(LAS u32x4*)(lds + j * 144 + c * 16) = olo; *(LAS u32x4*)(lds + j * 144 + 64 + c * 16) = ohi;
        }
#pragma unroll
        for (int i = 0; i < 4; ++i) {
            const int item = tid + 256 * i, d = item >> 4, ch = item & 15;
            *(LAS u32x4*)(lds + 18432 + d * 288 + ch * 16) = *(const u32x4*)(SB + (size_t)it3 * 8192 + d * 128 + ch * 8);
        }
        bf16x8 qf[2];
        const int qi = 16 * qt + fr;
        {
            const bf16_t* qr = hb + (size_t)(t0 + qi) * 3072 + h * 64 + 4 * fq;
            const uint2 a0 = *(const uint2*)qr, a1 = *(const uint2*)(qr + 16), b0 = *(const uint2*)(qr + 32), b1 = *(const uint2*)(qr + 48);
            const float2* rp = rope + (size_t)(n * 128 + qi) * 32 + 4 * fq;
            const float q1[8] = {bf_lo(a0.x), bf_hi(a0.x), bf_lo(a0.y), bf_hi(a0.y), bf_lo(a1.x), bf_hi(a1.x), bf_lo(a1.y), bf_hi(a1.y)};
            const float q2[8] = {bf_lo(b0.x), bf_hi(b0.x), bf_lo(b0.y), bf_hi(b0.y), bf_lo(b1.x), bf_hi(b1.x), bf_lo(b1.y), bf_hi(b1.y)};
            float r1[8], r2[8];
#pragma unroll
            for (int e = 0; e < 8; ++e) { const float2 cs = rp[e < 4 ? e : 12 + e]; r1[e] = q1[e] * cs.x - q2[e] * cs.y; r2[e] = q1[e] * cs.y + q2[e] * cs.x; }
            union { unsigned u[4]; bf16x8 v; } f0, f1;
#pragma unroll
            for (int e = 0; e < 4; ++e) { f0.u[e] = pack2(r1[2 * e], r1[2 * e + 1]); f1.u[e] = pack2(r2[2 * e], r2[2 * e + 1]); }
            qf[0] = f0.v; qf[1] = f1.v;
        }
        __syncthreads();
        f32x4 yacc[8];
#pragma unroll
        for (int et = 0; et < 8; ++et) yacc[et] = (f32x4){0.f, 0.f, 0.f, 0.f};
#pragma unroll
        for (int ks = 0; ks < 2; ++ks)
#pragma unroll
            for (int et = 0; et < 8; ++et) {
                const LAS unsigned char* a = lds + 18432 + (32 * ks + 4 * fq + (fr >> 2)) * 288 + 32 * et + 8 * (fr & 3);
                const bf16x8 sf = cat8(tr_read(a), tr_read(a + 16 * 288));
                yacc[et] = __builtin_amdgcn_mfma_f32_16x16x32_bf16(sf, qf[ks], yacc[et], 0, 0, 0);
            }
        {
            const float xi = __builtin_amdgcn_exp2f(lg2 * (float)(qi + 1));
#pragma unroll
            for (int et = 0; et < 8; ++et) yacc[et] *= xi;
        }
        f32x4 s[8];
#pragma unroll
        for (int nt = 0; nt < 8; ++nt) s[nt] = (f32x4){0.f, 0.f, 0.f, 0.f};
#pragma unroll
        for (int nt = 0; nt < 8; ++nt) {
            if (nt <= qt) {
#pragma unroll
                for (int ks = 0; ks < 2; ++ks) {
                    const LAS unsigned char* a = lds + (16 * nt + fr) * 144 + 64 * ks + 8 * fq;
                    const u32x2 k0 = *(const LAS u32x2*)a, k1 = *(const LAS u32x2*)(a + 32);
                    union { unsigned u[4]; bf16x8 v; } kf; kf.u[0] = k0.x; kf.u[1] = k0.y; kf.u[2] = k1.x; kf.u[3] = k1.y;
                    s[nt] = __builtin_amdgcn_mfma_f32_16x16x32_bf16(kf.v, qf[ks], s[nt], 0, 0, 0);
                }
            }
        }
#pragma unroll
        for (int nt = 0; nt < 8; ++nt)
#pragma unroll
            for (int rg = 0; rg < 4; ++rg) {
                const int j = 16 * nt + 4 * fq + rg;
                s[nt][rg] = j <= qi ? s[nt][rg] * __builtin_amdgcn_exp2f(lg2 * (float)(qi - j)) : 0.f;
            }
        bf16x8 pf[4];
#pragma unroll
        for (int c2 = 0; c2 < 4; ++c2) pf[c2] = pack8(s[2 * c2], s[2 * c2 + 1]);
        __syncthreads();
#pragma unroll
        for (int i = 0; i < 8; ++i) { const int item = tid + 256 * i, j = item >> 4, ch = item & 15; *(LAS u32x4*)(lds + j * 288 + ch * 16) = *(const u32x4*)(hb + (size_t)(t0 + j) * 3072 + 512 + h * 128 + ch * 8); }
        __syncthreads();
#pragma unroll
        for (int c2 = 0; c2 < 4; ++c2) {
            if (2 * c2 <= qt) {
#pragma unroll
                for (int et = 0; et < 8; ++et) {
                    const LAS unsigned char* a = lds + (32 * c2 + 4 * fq + (fr >> 2)) * 288 + 32 * et + 8 * (fr & 3);
                    const bf16x8 vf = cat8(tr_read(a), tr_read(a + 16 * 288));
                    yacc[et] = __builtin_amdgcn_mfma_f32_16x16x32_bf16(vf, pf[c2], yacc[et], 0, 0, 0);
                }
            }
        }
        {
            float s1 = 0.f;
#pragma unroll
            for (int et = 0; et < 8; ++et) s1 += (yacc[et][0] + yacc[et][1]) + (yacc[et][2] + yacc[et][3]);
            s1 += __shfl_xor(s1, 16); s1 += __shfl_xor(s1, 32);
            const float mu = s1 * (1.0f / 128.0f); float s2 = 0.f;
#pragma unroll
            for (int et = 0; et < 8; ++et) { yacc[et] -= mu; s2 += (yacc[et][0] * yacc[et][0] + yacc[et][1] * yacc[et][1]) + (yacc[et][2] * yacc[et][2] + yacc[et][3] * yacc[et][3]); }
            s2 += __shfl_xor(s2, 16); s2 += __shfl_xor(s2, 32);
            const float rstd = rsqrtf(s2 * (1.0f / 128.0f) + GN_EPS);
            const size_t t = (size_t)t0 + qi;
#pragma unroll
            for (int et = 0; et < 8; ++et) {
                const uint2 gv = *(const uint2*)(hb + t * 3072 + 1024 + h * 128 + 16 * et + 4 * fq);
                uint2 ov;
                ov.x = pack2(silu(bf_lo(gv.x)) * yacc[et][0] * rstd, silu(bf_hi(gv.x)) * yacc[et][1] * rstd);
                ov.y = pack2(silu(bf_lo(gv.y)) * yacc[et][2] * rstd, silu(bf_hi(gv.y)) * yacc[et][3] * rstd);
                *(uint2*)(y + t * 1024 + h * 128 + 16 * et + 4 * fq) = ov;
            }
        }
    }
}

__device__ void dil_naive(const Params& p) {
    const bf16_t* hb = (const bf16_t*)(p.ws + OFF_HB);
    bf16_t* odil = (bf16_t*)p.out;
    float* lse = (float*)(p.ws + OFF_LSE);
    const int lane = threadIdx.x & 63, wv = threadIdx.x >> 6;
    for (int it = blockIdx.x * 4 + wv; it < T_ * 8; it += gridDim.x * 4) {
        const int t = it >> 3, h = it & 7, pos = t & 8191;
        const float q = bf2f(hb[(size_t)t * 3072 + 1536 + h * 64 + lane]) * 0.125f;
#pragma unroll 1
        for (int c = 0; c < 3; ++c) {
            const int dil = c == 0 ? 1 : (c == 1 ? 4 : 16);
            float m = -1e30f, l = 0.f, acc = 0.f;
            for (int j = 0; j <= 128; ++j) {
                if (pos - j * dil < 0) break;
                const bf16_t* r = hb + (size_t)(t - j * dil) * 3072;
                const float s = wave_sum(q * bf2f(r[2048 + h * 64 + lane]));
                const float mn = fmaxf(m, s), sc = __expf(m - mn), pe = __expf(s - mn);
                l = l * sc + pe; acc = acc * sc + pe * bf2f(r[2560 + h * 64 + lane]); m = mn;
            }
            odil[((size_t)c * T_ + t) * 512 + h * 64 + lane] = (bf16_t)f2bf(acc / l);
            if (lane == 0) lse[((size_t)c * T_ + t) * 8 + h] = m + __logf(l);
        }
    }
}

__device__ void dil_mfma(const Params& p, float* sm) {
    LAS unsigned char* lds = (LAS unsigned char*)sm;
    const bf16_t* hb = (const bf16_t*)(p.ws + OFF_HB);
    bf16_t* odil = (bf16_t*)p.out;
    float* lse = (float*)(p.ws + OFF_LSE);
    const int tid = threadIdx.x, wid = __builtin_amdgcn_readfirstlane(tid >> 6), lane = tid & 63, fr = lane & 15, fq = lane >> 4, q0 = wid * 32;
    const float SC = 0.125f * 1.4426950408889634f;
#define DIL_DECODE(it_, br_, h_, n_, dil_, tb_) do { const int rem_ = (it_) & 1023, rn_ = rem_ & 63, dsh_ = ((it_) >> 10) * 2; br_ = (it_) >> 10; h_ = (rem_ >> 6) & 7; dil_ = 1 << dsh_; \
        n_ = rn_ >> dsh_; tb_ = (size_t)(rem_ >> 9) * 8192 + (rn_ & (dil_ - 1)); } while (0)
#define DIL_LOAD_KQ(h_, n_, dil_, tb_) do { _Pragma("unroll") for (int i = 0; i < 8; ++i) { int l_ = 128 * ((n_) - 1) + (tid >> 3) + 32 * i; l_ = l_ < 0 ? 0 : l_; \
            kreg[i] = *(const u32x4*)(hb + ((tb_) + (size_t)l_ * (dil_)) * 3072 + 2048 + (h_) * 64 + (tid & 7) * 8); } \
        _Pragma("unroll") for (int qt = 0; qt < 2; ++qt) _Pragma("unroll") for (int ks = 0; ks < 2; ++ks) { const int l_ = 128 * (n_) + q0 + 16 * qt + fr; \
            qf[qt][ks] = *(const bf16x8*)(hb + ((tb_) + (size_t)l_ * (dil_)) * 3072 + 1536 + (h_) * 64 + 32 * ks + 8 * fq); } } while (0)
    u32x4 kreg[8], vreg[8]; bf16x8 qf[2][2];
    int br = 0, h = 0, n = 0, dil = 1; size_t tb = 0;
#define DIL_MAP(L_) (((L_) & 7) * 384 + ((L_) >> 3))
    if ((int)blockIdx.x < 3072) { DIL_DECODE(DIL_MAP((int)blockIdx.x), br, h, n, dil, tb); DIL_LOAD_KQ(h, n, dil, tb); }
    for (int it = blockIdx.x; it < 3072; it += gridDim.x) {
        __syncthreads();
#pragma unroll
        for (int i = 0; i < 8; ++i) *(LAS u32x4*)(lds + ((tid >> 3) + 32 * i) * 144 + (tid & 7) * 16) = kreg[i];
        __syncthreads();
#pragma unroll
        for (int i = 0; i < 8; ++i) {
            int l = 128 * (n - 1) + (tid >> 3) + 32 * i; l = l < 0 ? 0 : l;
            vreg[i] = *(const u32x4*)(hb + (tb + (size_t)l * dil) * 3072 + 2560 + h * 64 + (tid & 7) * 8);
        }
        f32x4 s[2][10];
#pragma unroll
        for (int qt = 0; qt < 2; ++qt)
#pragma unroll
            for (int nt = 0; nt < 10; ++nt) s[qt][nt] = (f32x4){0.f, 0.f, 0.f, 0.f};
        __builtin_amdgcn_s_setprio(1);
#pragma unroll
        for (int nt = 0; nt < 10; ++nt)
#pragma unroll
            for (int ks = 0; ks < 2; ++ks) {
                const bf16x8 kf = *(const LAS bf16x8*)(lds + (q0 + 16 * nt + fr) * 144 + ks * 64 + fq * 16);
#pragma unroll
                for (int qt = 0; qt < 2; ++qt) s[qt][nt] = __builtin_amdgcn_mfma_f32_16x16x32_bf16(kf, qf[qt][ks], s[qt][nt], 0, 0, 0);
            }
        __builtin_amdgcn_s_setprio(0);
        __syncthreads();
#pragma unroll
        for (int i = 0; i < 8; ++i) *(LAS u32x4*)(lds + ((tid >> 3) + 32 * i) * 160 + (tid & 7) * 16) = vreg[i];
        const int itn = it + gridDim.x; int nbr = 0, nh = 0, nn = 0, ndil = 1; size_t ntb = 0;
        if (itn < 3072) { DIL_DECODE(DIL_MAP(itn), nbr, nh, nn, ndil, ntb); DIL_LOAD_KQ(nh, nn, ndil, ntb); }
        float mrow[2], lrow[2];
#pragma unroll
        for (int qt = 0; qt < 2; ++qt) {
            float m = -1e30f;
#pragma unroll
            for (int nt = 0; nt < 10; ++nt)
#pragma unroll
                for (int rg = 0; rg < 4; ++rg) {
                    const int diff = 16 * (nt - qt) + 4 * fq + rg - fr, kj = q0 + 16 * nt + 4 * fq + rg;
                    const bool valid = diff >= 0 && diff <= 128 && (n > 0 || kj >= 128);
                    const float v = valid ? s[qt][nt][rg] * SC : -1e30f;
                    s[qt][nt][rg] = v; m = fmaxf(m, v);
                }
            m = fmaxf(m, __shfl_xor(m, 16)); m = fmaxf(m, __shfl_xor(m, 32));
            float l = 0.f;
#pragma unroll
            for (int nt = 0; nt < 10; ++nt)
#pragma unroll
                for (int rg = 0; rg < 4; ++rg) { const float pe = __builtin_amdgcn_exp2f(s[qt][nt][rg] - m); s[qt][nt][rg] = pe; l += pe; }
            l += __shfl_xor(l, 16); l += __shfl_xor(l, 32);
            mrow[qt] = m; lrow[qt] = l;
        }
        __syncthreads();
        f32x4 o[2][4];
#pragma unroll
        for (int qt = 0; qt < 2; ++qt)
#pragma unroll
            for (int dt = 0; dt < 4; ++dt) o[qt][dt] = (f32x4){0.f, 0.f, 0.f, 0.f};
        __builtin_amdgcn_s_setprio(1);
#pragma unroll
        for (int c2 = 0; c2 < 5; ++c2) {
            bf16x8 pf[2];
#pragma unroll
            for (int qt = 0; qt < 2; ++qt) pf[qt] = pack8(s[qt][2 * c2], s[qt][2 * c2 + 1]);
#pragma unroll
            for (int dt = 0; dt < 4; ++dt) {
                const LAS unsigned char* a = lds + (q0 + 32 * c2 + 4 * fq + (fr >> 2)) * 160 + (16 * dt + 4 * (fr & 3)) * 2;
                const bf16x8 vf = cat8(tr_read(a), tr_read(a + 16 * 160));
#pragma unroll
                for (int qt = 0; qt < 2; ++qt) o[qt][dt] = __builtin_amdgcn_mfma_f32_16x16x32_bf16(vf, pf[qt], o[qt][dt], 0, 0, 0);
            }
        }
        __builtin_amdgcn_s_setprio(0);
#pragma unroll
        for (int qt = 0; qt < 2; ++qt) {
            const int l = 128 * n + q0 + 16 * qt + fr; const size_t t = tb + (size_t)l * dil; const float inv = 1.0f / lrow[qt];
#pragma unroll
            for (int dt = 0; dt < 4; ++dt) {
                uint2 ov; ov.x = pack2(o[qt][dt][0] * inv, o[qt][dt][1] * inv); ov.y = pack2(o[qt][dt][2] * inv, o[qt][dt][3] * inv);
                *(uint2*)(odil + ((size_t)br * T_ + t) * 512 + h * 64 + 16 * dt + 4 * fq) = ov;
            }
            if (fq == 0) lse[((size_t)br * T_ + t) * 8 + h] = (mrow[qt] + __log2f(lrow[qt])) * 0.6931471805599453f;
        }
        br = nbr; h = nh; n = nn; dil = ndil; tb = ntb;
    }
#undef DIL_DECODE
#undef DIL_MAP
#undef DIL_LOAD_KQ
}

__device__ void dil_merge(const Params& p) {
    const bf16_t* odil = (const bf16_t*)p.out;
    const float* lse = (const float*)(p.ws + OFF_LSE);
    bf16_t* y = (bf16_t*)(p.ws + OFF_RB);
    for (int g = blockIdx.x * 256 + threadIdx.x; g < T_ * 64; g += gridDim.x * 256) {
        const int t = g >> 6, c8 = (g & 63) * 8, h = c8 >> 6;
        const float l0 = lse[(size_t)t * 8 + h], l1 = lse[((size_t)T_ + t) * 8 + h], l2 = lse[((size_t)2 * T_ + t) * 8 + h];
        const u32x4 a_ = __builtin_nontemporal_load((const u32x4*)(odil + (size_t)t * 512 + c8)), b_ = __builtin_nontemporal_load((const u32x4*)(odil + ((size_t)T_ + t) * 512 + c8)), c_ = __builtin_nontemporal_load((const u32x4*)(odil + ((size_t)2 * T_ + t) * 512 + c8));
        const uint4 a = make_uint4(a_[0], a_[1], a_[2], a_[3]), b = make_uint4(b_[0], b_[1], b_[2], b_[3]), c = make_uint4(c_[0], c_[1], c_[2], c_[3]);
        const float mx = fmaxf(l0, fmaxf(l1, l2));
        float w0 = __expf(l0 - mx), w1 = __expf(l1 - mx), w2 = __expf(l2 - mx); const float inv = 1.0f / (w0 + w1 + w2); w0 *= inv; w1 *= inv; w2 *= inv;
        const unsigned aw[4] = {a.x, a.y, a.z, a.w}, bw[4] = {b.x, b.y, b.z, b.w}, cw[4] = {c.x, c.y, c.z, c.w};
        unsigned ow[4];
#pragma unroll
        for (int j = 0; j < 4; ++j) ow[j] = pack2(w0 * bf_lo(aw[j]) + w1 * bf_lo(bw[j]) + w2 * bf_lo(cw[j]), w0 * bf_hi(aw[j]) + w1 * bf_hi(bw[j]) + w2 * bf_hi(cw[j]));
        *(uint4*)(y + (size_t)t * 1024 + 512 + c8) = make_uint4(ow[0], ow[1], ow[2], ow[3]);
    }
}

template <bool ROUTE>
__device__ void ln_pass(const Params& p, const float* __restrict__ v, const float* __restrict__ g, const float* __restrict__ bta, float* __restrict__ of, bf16_t* __restrict__ ob, float* sm) {
    const int lane = threadIdx.x & 63, wv = threadIdx.x >> 6;
    for (int row = blockIdx.x * 4 + wv; row < T_; row += gridDim.x * 4) {
        float4 a[4]; float s = 0.f;
#pragma unroll
        for (int i = 0; i < 4; ++i) { a[i] = *(const float4*)(v + (size_t)row * D_ + i * 256 + lane * 4); s += (a[i].x + a[i].y) + (a[i].z + a[i].w); }
        const float mu = wave_sum(s) * (1.0f / 1024.0f); float q = 0.f;
#pragma unroll
        for (int i = 0; i < 4; ++i) { a[i].x -= mu; a[i].y -= mu; a[i].z -= mu; a[i].w -= mu; q += (a[i].x * a[i].x + a[i].y * a[i].y) + (a[i].z * a[i].z + a[i].w * a[i].w); }
        const float rstd = rsqrtf(wave_sum(q) * (1.0f / 1024.0f) + LN_EPS);
#pragma unroll
        for (int i = 0; i < 4; ++i) {
            const int c = i * 256 + lane * 4; const float4 gg = *(const float4*)(g + c), bb = *(const float4*)(bta + c);
            a[i].x = a[i].x * rstd * gg.x + bb.x; a[i].y = a[i].y * rstd * gg.y + bb.y; a[i].z = a[i].z * rstd * gg.z + bb.z; a[i].w = a[i].w * rstd * gg.w + bb.w;
            if (of) *(float4*)(of + (size_t)row * D_ + c) = a[i];
            uint2 o; o.x = pack2(a[i].x, a[i].y); o.y = pack2(a[i].z, a[i].w); *(uint2*)(ob + (size_t)row * D_ + c) = o;
        }
        if (ROUTE) {
            float lg[36];
#pragma unroll
            for (int c = 0; c < 36; ++c) lg[c] = 0.f;
            float* xr = sm + wv * 1024;
#pragma unroll
            for (int i = 0; i < 4; ++i) *(float4*)(xr + i * 256 + lane * 4) = a[i];
            asm volatile("" ::: "memory");
#pragma unroll 1
            for (int kk = 0; kk < 16; ++kk) {
                const int k = kk * 64 + lane; const float xv = xr[k];
                const float4 wg = *(const float4*)(p.w_rg + (size_t)k * 4);
                lg[0] += xv * wg.x; lg[1] += xv * wg.y; lg[2] += xv * wg.z; lg[3] += xv * wg.w;
#pragma unroll
                for (int c = 0; c < 8; ++c) {
                    const float4 we = *(const float4*)(p.w_re + (size_t)k * 32 + c * 4);
                    lg[4 + c * 4] += xv * we.x; lg[5 + c * 4] += xv * we.y; lg[6 + c * 4] += xv * we.z; lg[7 + c * 4] += xv * we.w;
                }
            }
            asm volatile("" ::: "memory");
#pragma unroll
            for (int c = 0; c < 36; ++c) lg[c] = wave_sum(lg[c]);
            int gi = 0; float gm = lg[0];
#pragma unroll
            for (int c = 1; c < 4; ++c) if (lg[c] > gm) { gm = lg[c]; gi = c; }
            float den = 0.f;
#pragma unroll
            for (int c = 0; c < 4; ++c) den += __expf(lg[c] - gm);
            const float g1 = 1.0f / den;
            float ev[8];
#pragma unroll
            for (int c = 0; c < 8; ++c) ev[c] = gi == 0 ? lg[4 + c] : (gi == 1 ? lg[12 + c] : (gi == 2 ? lg[20 + c] : lg[28 + c]));
            int i1 = 0; float v1 = ev[0];
#pragma unroll
            for (int c = 1; c < 8; ++c) if (ev[c] > v1) { v1 = ev[c]; i1 = c; }
            int i2 = -1; float v2 = -3.0e38f;
#pragma unroll
            for (int c = 0; c < 8; ++c) if (c != i1 && ev[c] > v2) { v2 = ev[c]; i2 = c; }
            const float e2 = __expf(v2 - v1), ga = g1 / (1.0f + e2), gb = g1 * e2 / (1.0f + e2);
            if (lane == 0) {
                int* cnt = (int*)(p.ws + OFF_CNT); int* eid = (int*)(p.ws + OFF_EID); float* gate = (float*)(p.ws + OFF_GATE); int* rank = (int*)(p.ws + OFF_RANK);
                const int ea = gi * 8 + i1, eb = gi * 8 + i2;
                eid[row * 2] = ea; eid[row * 2 + 1] = eb; gate[row * 2] = ga; gate[row * 2 + 1] = gb;
                rank[row * 2] = atomicAdd(cnt + ea, 1); rank[row * 2 + 1] = atomicAdd(cnt + eb, 1);
            }
        }
    }
}


constexpr size_t OFF_WR = OFF_MISC + 816 * 1024;
__device__ void route_prep(const Params& p, int vb, int nvb) {
    float* Wp = (float*)(p.ws + OFF_WR);
    for (int i = vb * 256 + threadIdx.x; i < 1024 * 48; i += nvb * 256) {
        const int k = i / 48, cc = i % 48, cgp = cc / 12, cl = cc % 12, c = cgp * 9 + cl;
        Wp[i] = cl < 9 ? p.ln_x_g[k] * (c < 4 ? p.w_rg[k * 4 + c] : p.w_re[k * 32 + c - 4]) : 0.f;
    }
    if (vb < 36 && threadIdx.x < 64) {
        const int c = vb, l = threadIdx.x; float G = 0.f, B = 0.f;
#pragma unroll
        for (int j = 0; j < 16; ++j) { const int k = j * 64 + l; const float w = c < 4 ? p.w_rg[k * 4 + c] : p.w_re[k * 32 + c - 4]; G += p.ln_x_g[k] * w; B += p.ln_x_b[k] * w; }
        G = wave_sum(G); B = wave_sum(B);
        if (l == 0) { Wp[1024 * 48 + c] = G; Wp[1024 * 48 + 36 + c] = B; }
    }
}

__device__ void deferred_prep(const Params& p, float* sm, int vb, int nvb) {
    route_prep(p, vb, nvb);
    transpose_tiles(p.w_out, 1024, 1024, 1, (bf16_t*)(p.ws + OFF_WOUT), 0, 0, sm, nullptr, vb, nvb);
    transpose_tiles(p.w_xq, 1024, 1024, 1, (bf16_t*)(p.ws + OFF_WXQ), 0, 0, sm, p.ln_mix_g, vb, nvb);
    transpose_tiles(p.w_xo, 1024, 1024, 1, (bf16_t*)(p.ws + OFF_WXO), 0, 0, sm, nullptr, vb, nvb);
    if (vb < 64) {
        const int t = threadIdx.x, col = vb * 16 + (t & 15), kg = t >> 4; float G = 0.f, B = 0.f;
#pragma unroll 8
        for (int k = kg * 64; k < kg * 64 + 64; ++k) { const float w = p.w_xq[(size_t)k * 1024 + col]; G += p.ln_mix_g[k] * w; B += p.ln_mix_b[k] * w; }
        __syncthreads();
        sm[t * 2] = G; sm[t * 2 + 1] = B;
        __syncthreads();
        if (t < 16) { float g = 0.f, b = 0.f; for (int q = 0; q < 16; ++q) { g += sm[(q * 16 + t) * 2]; b += sm[(q * 16 + t) * 2 + 1]; }
            float* gb = (float*)(p.ws + OFF_MISC + 1010 * 1024); gb[col] = g; gb[1024 + col] = b; }
        __syncthreads();
    }
}

__device__ void route_tasks(const Params& p, const float* __restrict__ v, float* sm) {
    float* As = sm;
    float* LG = sm + 2112;
    float* ST = sm + 4480;
    int* cntl = (int*)(sm + 4608);
    int* basel = (int*)(sm + 4640);
    float* Ws = sm + 4672;
    const float* __restrict__ Wp = (const float*)(p.ws + OFF_WR);
    const float* __restrict__ GB = Wp + 1024 * 48;
    int* cnt = (int*)(p.ws + OFF_CNT); int* eid = (int*)(p.ws + OFF_EID); float* gate = (float*)(p.ws + OFF_GATE); int* rank = (int*)(p.ws + OFF_RANK);
    const int tid = threadIdx.x, r = tid & 31, cg = (tid >> 5) & 3, kh = tid >> 7;
    for (int it = blockIdx.x; it < T_ / 32; it += gridDim.x) {
        const int row0 = it * 32;
        float acc[9]; float s1 = 0.f, s2 = 0.f;
#pragma unroll
        for (int c = 0; c < 9; ++c) acc[c] = 0.f;
        for (int k0 = 0; k0 < 1024; k0 += 64) {
            __syncthreads();
#pragma unroll
            for (int i = 0; i < 2; ++i) {
                const int idx = tid + 256 * i, row = idx >> 4, c4 = idx & 15;
                const float4 a = *(const float4*)(v + (size_t)(row0 + row) * 1024 + k0 + c4 * 4);
                float* d = As + row * 65 + c4 * 4; d[0] = a.x; d[1] = a.y; d[2] = a.z; d[3] = a.w;
            }
#pragma unroll
            for (int i = 0; i < 3; ++i) *(float4*)(Ws + (tid + 256 * i) * 4) = *(const float4*)(Wp + (size_t)k0 * 48 + (tid + 256 * i) * 4);
            __syncthreads();
            const float* wk = Ws + (kh * 32) * 48 + cg * 12; const float* ak = As + r * 65 + kh * 32;
#pragma unroll 8
            for (int k = 0; k < 32; ++k) {
                const float a = ak[k]; s1 += a; s2 += a * a;
                const float4 w0 = *(const float4*)(wk + k * 48), w1 = *(const float4*)(wk + k * 48 + 4); const float w8 = wk[k * 48 + 8];
                acc[0] += a * w0.x; acc[1] += a * w0.y; acc[2] += a * w0.z; acc[3] += a * w0.w;
                acc[4] += a * w1.x; acc[5] += a * w1.y; acc[6] += a * w1.z; acc[7] += a * w1.w; acc[8] += a * w8;
            }
        }
#pragma unroll
        for (int c = 0; c < 9; ++c) LG[(kh * 32 + r) * 37 + cg * 9 + c] = acc[c];
        if (cg == 0) { ST[(kh * 32 + r) * 2] = s1; ST[(kh * 32 + r) * 2 + 1] = s2; }
        if (tid < 32) cntl[tid] = 0;
        __syncthreads();
        int ea = 0, eb = 0, ra = 0, rb = 0; float ga = 0.f, gb = 0.f;
        if (tid < 32) {
            const float t1 = ST[tid * 2] + ST[(32 + tid) * 2], t2 = ST[tid * 2 + 1] + ST[(32 + tid) * 2 + 1];
            const float mu = t1 * (1.0f / 1024.0f), rstd = rsqrtf(t2 * (1.0f / 1024.0f) - mu * mu + LN_EPS);
            float lg[36];
#pragma unroll
            for (int c = 0; c < 36; ++c) lg[c] = rstd * ((LG[tid * 37 + c] + LG[(32 + tid) * 37 + c]) - mu * GB[c]) + GB[36 + c];
            int gi = 0; float gm = lg[0];
#pragma unroll
            for (int c = 1; c < 4; ++c) if (lg[c] > gm) { gm = lg[c]; gi = c; }
            float den = 0.f;
#pragma unroll
            for (int c = 0; c < 4; ++c) den += __expf(lg[c] - gm);
            const float g1 = 1.0f / den;
            float ev[8];
#pragma unroll
            for (int c = 0; c < 8; ++c) ev[c] = gi == 0 ? lg[4 + c] : (gi == 1 ? lg[12 + c] : (gi == 2 ? lg[20 + c] : lg[28 + c]));
            int i1 = 0; float v1 = ev[0];
#pragma unroll
            for (int c = 1; c < 8; ++c) if (ev[c] > v1) { v1 = ev[c]; i1 = c; }
            int i2 = -1; float v2 = -3.0e38f;
#pragma unroll
            for (int c = 0; c < 8; ++c) if (c != i1 && ev[c] > v2) { v2 = ev[c]; i2 = c; }
            const float e2 = __expf(v2 - v1); ga = g1 / (1.0f + e2); gb = g1 * e2 / (1.0f + e2);
            ea = gi * 8 + i1; eb = gi * 8 + i2;
            ra = atomicAdd(cntl + ea, 1); rb = atomicAdd(cntl + eb, 1);
        }
        __syncthreads();
        if (tid < 32) { const int c = cntl[tid]; basel[tid] = c ? atomicAdd(cnt + tid, c) : 0; }
        __syncthreads();
        if (tid < 32) {
            const int row = row0 + tid;
            eid[row * 2] = ea; eid[row * 2 + 1] = eb; gate[row * 2] = ga; gate[row * 2 + 1] = gb;
            const int rka = basel[ea] + ra, rkb = basel[eb] + rb;
            rank[row * 2] = rka; rank[row * 2 + 1] = rkb;
            int* rte = (int*)(p.ws + OFF_ROPE);
            rte[ea * 16384 + rka] = row; rte[eb * 16384 + rkb] = row;
        }
    }
}

__device__ void xattn_naive(const Params& p, float* sm) {
    const bf16_t* qx = (const bf16_t*)(p.ws + OFF_RB);
    const bf16_t* kvb = (const bf16_t*)(p.ws + OFF_KVB);
    bf16_t* ob = (bf16_t*)(p.ws + OFF_OB);
    float* qs = sm; float* ps = sm + 256; float* red = sm + 512;
    const int tid = threadIdx.x;
    for (int it = blockIdx.x; it < T_ * 4; it += gridDim.x) {
        const int t = it >> 2, h = it & 3, b = t >> 13;
        __syncthreads();
        qs[tid] = bf2f(qx[(size_t)t * 1024 + h * 256 + tid]);
        __syncthreads();
        const bf16_t* kr = kvb + (size_t)(b * 256 + tid) * 2048 + h * 256;
        float s = 0.f;
        for (int d = 0; d < 256; d += 2) { const unsigned u = *(const unsigned*)(kr + d); s += qs[d] * bf_lo(u) + qs[d + 1] * bf_hi(u); }
        s *= 0.0625f;
        const float wm = wave_max(s);
        if ((tid & 63) == 0) red[tid >> 6] = wm;
        __syncthreads();
        const float mx = fmaxf(fmaxf(red[0], red[1]), fmaxf(red[2], red[3]));
        const float pe = __expf(s - mx);
        ps[tid] = pe;
        const float ws_ = wave_sum(pe);
        if ((tid & 63) == 0) red[4 + (tid >> 6)] = ws_;
        __syncthreads();
        const float den = (red[4] + red[5]) + (red[6] + red[7]);
        float o = 0.f;
        const bf16_t* vr = kvb + (size_t)(b * 256) * 2048 + 1024 + h * 256 + tid;
        for (int m = 0; m < 256; ++m) o += ps[m] * bf2f(vr[(size_t)m * 2048]);
        ob[(size_t)t * 1024 + h * 256 + tid] = (bf16_t)f2bf(o / den);
    }
}


template <int NQT>
__device__ void xattn_mfma(const Params& p, float* sm) {
    LAS unsigned char* lds = (LAS unsigned char*)sm;
    const bf16_t* qx = (const bf16_t*)(p.ws + OFF_RB);
    const bf16_t* kvb = (const bf16_t*)(p.ws + OFF_KVB);
    bf16_t* ob = (bf16_t*)(p.ws + OFF_OB);
    const int tid = threadIdx.x, wid = __builtin_amdgcn_readfirstlane(tid >> 6), lane = tid & 63, fr = lane & 15, fq = lane >> 4;
    constexpr int QROWS = 64 * NQT, NTASK = (T_ / QROWS) * 4;
    const float SC = 0.0625f * 1.4426950408889634f;
    for (int it = blockIdx.x; it < NTASK; it += gridDim.x) {
        const int h = it & 3, t0 = (it >> 2) * QROWS, b = t0 >> 13;
        const bf16_t* kbase = kvb + (size_t)(b * 256 + (tid >> 5)) * 2048 + h * 256 + (tid & 31) * 8;
        u32x4 regs[8];
#pragma unroll
        for (int i = 0; i < 8; ++i) regs[i] = *(const u32x4*)(kbase + (size_t)(8 * i) * 2048);
        bf16x8 qf[NQT][8];
#pragma unroll
        for (int qt = 0; qt < NQT; ++qt)
#pragma unroll
            for (int ks = 0; ks < 8; ++ks) qf[qt][ks] = *(const bf16x8*)(qx + (size_t)(t0 + (wid * NQT + qt) * 16 + fr) * 1024 + h * 256 + 32 * ks + 8 * fq);
        f32x4 s[NQT][16];
        f32x4 o[NQT][16];
        float lrow[NQT];
#pragma unroll
        for (int qt = 0; qt < NQT; ++qt)
#pragma unroll
            for (int g = 0; g < 16; ++g) { s[qt][g] = (f32x4){0.f, 0.f, 0.f, 0.f}; o[qt][g] = (f32x4){0.f, 0.f, 0.f, 0.f}; }
#pragma unroll
        for (int st = 0; st < 8; ++st) {
            const int rs = st < 4 ? 528 : 544;
            __syncthreads();
#pragma unroll
            for (int i = 0; i < 8; ++i) *(LAS u32x4*)(lds + ((tid >> 5) + 8 * i) * rs + (tid & 31) * 16) = regs[i];
            __syncthreads();
            if (st < 7) {
                const int nx = st + 1; const bf16_t* nb = kbase + (size_t)((nx & 3) * 64) * 2048 + (nx >= 4 ? 1024 : 0);
#pragma unroll
                for (int i = 0; i < 8; ++i) regs[i] = *(const u32x4*)(nb + (size_t)(8 * i) * 2048);
            }
            if (st < 4) {
                __builtin_amdgcn_s_setprio(1);
#pragma unroll
                for (int nt = 0; nt < 4; ++nt)
#pragma unroll
                    for (int ks = 0; ks < 8; ++ks) {
                        const bf16x8 kf = *(const LAS bf16x8*)(lds + (16 * nt + fr) * 528 + ks * 64 + fq * 16);
#pragma unroll
                        for (int qt = 0; qt < NQT; ++qt) s[qt][st * 4 + nt] = __builtin_amdgcn_mfma_f32_16x16x32_bf16(kf, qf[qt][ks], s[qt][st * 4 + nt], 0, 0, 0);
                    }
                __builtin_amdgcn_s_setprio(0);
                if (st == 3) {
#pragma unroll
                    for (int qt = 0; qt < NQT; ++qt) {
                        float m = -1e30f;
#pragma unroll
                        for (int g = 0; g < 16; ++g)
#pragma unroll
                            for (int rg = 0; rg < 4; ++rg) { const float v = s[qt][g][rg] * SC; s[qt][g][rg] = v; m = fmaxf(m, v); }
                        m = fmaxf(m, __shfl_xor(m, 16)); m = fmaxf(m, __shfl_xor(m, 32));
                        float l = 0.f;
#pragma unroll
                        for (int g = 0; g < 16; ++g)
#pragma unroll
                            for (int rg = 0; rg < 4; ++rg) { const float pe = __builtin_amdgcn_exp2f(s[qt][g][rg] - m); s[qt][g][rg] = pe; l += pe; }
                        l += __shfl_xor(l, 16); l += __shfl_xor(l, 32);
                        lrow[qt] = l;
                    }
                }
            } else {
                const int vc = st - 4;
                __builtin_amdgcn_s_setprio(1);
#pragma unroll
                for (int c2 = 0; c2 < 2; ++c2) {
                    bf16x8 pf[NQT];
#pragma unroll
                    for (int qt = 0; qt < NQT; ++qt) pf[qt] = pack8(s[qt][2 * (vc * 2 + c2)], s[qt][2 * (vc * 2 + c2) + 1]);
#pragma unroll
                    for (int dt = 0; dt < 16; ++dt) {
                        const LAS unsigned char* a = lds + (32 * c2 + 4 * fq + (fr >> 2)) * 544 + (16 * dt + 4 * (fr & 3)) * 2;
                        const bf16x8 vf = cat8(tr_read(a), tr_read(a + 16 * 544));
#pragma unroll
                        for (int qt = 0; qt < NQT; ++qt) o[qt][dt] = __builtin_amdgcn_mfma_f32_16x16x32_bf16(vf, pf[qt], o[qt][dt], 0, 0, 0);
                    }
                }
                __builtin_amdgcn_s_setprio(0);
            }
        }
#pragma unroll
        for (int qt = 0; qt < NQT; ++qt) {
            const float inv = 1.0f / lrow[qt];
            bf16_t* orow = ob + (size_t)(t0 + (wid * NQT + qt) * 16 + fr) * 1024 + h * 256 + 4 * fq;
#pragma unroll
            for (int dt = 0; dt < 16; ++dt) {
                uint2 ov; ov.x = pack2(o[qt][dt][0] * inv, o[qt][dt][1] * inv); ov.y = pack2(o[qt][dt][2] * inv, o[qt][dt][3] * inv);
                *(uint2*)(orow + 16 * dt) = ov;
            }
        }
    }
}

__device__ void moe_dest(const Params& p, float* sm) {
    const int* cnt = (const int*)(p.ws + OFF_CNT); const int* eid = (const int*)(p.ws + OFF_EID); const int* rank = (const int*)(p.ws + OFF_RANK);
    int* dest = (int*)(p.ws + OFF_DEST); int* rtok = (int*)(p.ws + OFF_RTOK);
    int* poff = (int*)sm;
    __syncthreads();
    if (threadIdx.x < 64) {
        const int l = threadIdx.x; const int pc = l < 32 ? ((cnt[l & 31] + 127) & ~127) : 0; int incl = pc;
#pragma unroll
        for (int o = 1; o < 32; o <<= 1) { const int t = __shfl_up(incl, o); if (l >= o) incl += t; }
        if (l < 32) poff[l] = incl - pc;
    }
    __syncthreads();
    for (int a = blockIdx.x * 256 + threadIdx.x; a < T_ * 2; a += gridDim.x * 256) {
        const int d = poff[eid[a]] + rank[a];
        dest[a] = d; rtok[d] = a >> 1;
    }
}
__device__ __forceinline__ int padded_end_lane(const int* cnt) {
    const int l = threadIdx.x & 63; const int pc = l < 32 ? ((cnt[l & 31] + 127) & ~127) : 0; int incl = pc;
#pragma unroll
    for (int o = 1; o < 32; o <<= 1) { const int t = __shfl_up(incl, o); if (l >= o) incl += t; }
    return l < 32 ? incl : 0x7fffffff;
}
__device__ __forceinline__ int tile_expert(int pend, int row0) {
    const int e = __popcll(__ballot(pend <= row0));
    return e < 32 ? e : -1;
}
__device__ void moe_gu_naive(const Params& p, float* sm) {
    const int* cnt = (const int*)(p.ws + OFF_CNT); const int* rtok = (const int*)(p.ws + OFF_ROPE);
    const bf16_t* x2b = (const bf16_t*)(p.ws + OFF_RB); const bf16_t* W = (const bf16_t*)(p.ws + OFF_WGU);
    EpiGU8 epi{(bf16_t*)(p.ws + OFF_HEXP)};
    const int pend = padded_end_lane(cnt);
    const int ntv = (__shfl(pend, 31) >> 7) * 8;
    for (int L = blockIdx.x; L < ntv; L += gridDim.x) {
        const int it = (L & 7) * (ntv >> 3) + (L >> 3);
        const int row0 = (it >> 3) * 128, col0 = (it & 7) * 128, e = tile_expert(pend, row0);
        if (e < 0) continue;
        const int ce = cnt[e], lr0 = row0 - (__shfl(pend, e) - ((ce + 127) & ~127));
        gemm_tile128(x2b, 1024, rtok + e * 16384 + lr0, row0, W + (size_t)e * 1024 * 1024, 1024, col0, 1024, epi, sm, ce - lr0);
    }
}
__device__ void moe_down_naive(const Params& p, float* sm) {
    const int* cnt = (const int*)(p.ws + OFF_CNT);
    const bf16_t* H = (const bf16_t*)(p.ws + OFF_HEXP); const bf16_t* W = (const bf16_t*)(p.ws + OFF_WD);
    EpiBf16P epi{(bf16_t*)(p.ws + OFF_YEXP), 1024};
    const int pend = padded_end_lane(cnt);
    const int ntv = (__shfl(pend, 31) >> 7) * 8;
    for (int L = blockIdx.x; L < ntv; L += gridDim.x) {
        const int it = (L & 7) * (ntv >> 3) + (L >> 3);
        const int row0 = (it >> 3) * 128, col0 = (it & 7) * 128, e = tile_expert(pend, row0);
        if (e < 0) continue;
        gemm_tile128(H, 512, nullptr, row0, W + (size_t)e * 1024 * 512, 512, col0, 512, epi, sm);
    }
}
__device__ void final_ln(const Params& p) {
    const int* eid = (const int*)(p.ws + OFF_EID); const int* rank = (const int*)(p.ws + OFF_RANK); const float* gate = (const float*)(p.ws + OFF_GATE);
    const int* cnt = (const int*)(p.ws + OFF_CNT);
    const int pend = padded_end_lane(cnt);
    const int poffl = pend - (((threadIdx.x & 63) < 32 ? cnt[threadIdx.x & 31] : 0) + 127 & ~127);
    const bf16_t* Y = (const bf16_t*)(p.ws + OFF_YEXP);
    const bf16_t* x2b = (const bf16_t*)(p.ws + OFF_RB);
    const int lane = threadIdx.x & 63, wv = threadIdx.x >> 6;
    const int stride = gridDim.x * 4;
    for (int row = blockIdx.x * 4 + wv; row < T_; row += 2 * stride) {
        int rr[2]; rr[0] = row; rr[1] = row + stride < T_ ? row + stride : row;
        int2 ee[2], rk[2]; float2 gg2[2];
#pragma unroll
        for (int u = 0; u < 2; ++u) { ee[u] = *(const int2*)(eid + rr[u] * 2); rk[u] = *(const int2*)(rank + rr[u] * 2); gg2[u] = *(const float2*)(gate + rr[u] * 2); }
        uint2 xr[2][4], y0[2][4], y1[2][4];
#pragma unroll
        for (int u = 0; u < 2; ++u) {
            const int d0 = __shfl(poffl, ee[u].x) + rk[u].x, d1 = __shfl(poffl, ee[u].y) + rk[u].y;
#pragma unroll
            for (int i = 0; i < 4; ++i) {
                const int c = i * 256 + lane * 4;
                xr[u][i] = *(const uint2*)(x2b + (size_t)rr[u] * D_ + c); y0[u][i] = *(const uint2*)(Y + (size_t)d0 * D_ + c); y1[u][i] = *(const uint2*)(Y + (size_t)d1 * D_ + c);
            }
        }
#pragma unroll
        for (int u = 0; u < 2; ++u) {
            if (u == 1 && rr[1] == rr[0]) break;
            const float g0 = gg2[u].x, g1 = gg2[u].y;
            float4 a[4]; float s = 0.f;
#pragma unroll
            for (int i = 0; i < 4; ++i) {
                a[i].x = ALPHA * bf_lo(xr[u][i].x) + g0 * bf_lo(y0[u][i].x) + g1 * bf_lo(y1[u][i].x); a[i].y = ALPHA * bf_hi(xr[u][i].x) + g0 * bf_hi(y0[u][i].x) + g1 * bf_hi(y1[u][i].x);
                a[i].z = ALPHA * bf_lo(xr[u][i].y) + g0 * bf_lo(y0[u][i].y) + g1 * bf_lo(y1[u][i].y); a[i].w = ALPHA * bf_hi(xr[u][i].y) + g0 * bf_hi(y0[u][i].y) + g1 * bf_hi(y1[u][i].y);
                s += (a[i].x + a[i].y) + (a[i].z + a[i].w);
            }
            const float mu = wave_sum(s) * (1.0f / 1024.0f); float q = 0.f;
#pragma unroll
            for (int i = 0; i < 4; ++i) { a[i].x -= mu; a[i].y -= mu; a[i].z -= mu; a[i].w -= mu; q += (a[i].x * a[i].x + a[i].y * a[i].y) + (a[i].z * a[i].z + a[i].w * a[i].w); }
            const float rstd = rsqrtf(wave_sum(q) * (1.0f / 1024.0f) + LN_EPS);
#pragma unroll
            for (int i = 0; i < 4; ++i) {
                const int c = i * 256 + lane * 4; const float4 gg = *(const float4*)(p.ln_moe_g + c), bb = *(const float4*)(p.ln_moe_b + c);
                *(float4*)(p.out + (size_t)rr[u] * D_ + c) = make_float4(a[i].x * rstd * gg.x + bb.x, a[i].y * rstd * gg.y + bb.y, a[i].z * rstd * gg.z + bb.z, a[i].w * rstd * gg.w + bb.w);
            }
        }
    }
}

__device__ __forceinline__ void gemm1_phase(const Params& p, float* sm) {
    const bf16_t* A = (const bf16_t*)(p.ws + OFF_RB); const bf16_t* Bt = (const bf16_t*)(p.ws + OFF_WIN);
    EpiBf16P epi{(bf16_t*)(p.ws + OFF_HB), 3072};
    const int ntile = 128 * 24, nt8 = ntile >> 3;
    bool pre = false;
    for (int L = blockIdx.x; L < ntile; L += gridDim.x) {
        const int x = L & 7, q = L >> 3, patch = q >> 6, w = q & 63;
        const int mt = x * 16 + (patch / 3) * 8 + (w >> 3), nt = (patch % 3) * 8 + (w & 7);
        const int Ln = L + gridDim.x; int nmt = -1, nnt = 0;
        if (Ln < ntile) { const int q2 = Ln >> 3, p2 = q2 >> 6, w2 = q2 & 63; nmt = (Ln & 7) * 16 + (p2 / 3) * 8 + (w2 >> 3); nnt = (p2 % 3) * 8 + (w2 & 7); }
        gemm_tile128(A, 1024, nullptr, mt * 128, Bt, 1024, nt * 128, 1024, epi, sm, 128, pre, nmt < 0 ? -1 : nmt * 128, nnt * 128);
        pre = nmt >= 0;
#pragma unroll 1
        for (int j = 0; j < 4; ++j) expert_transpose_tile(p, L * 4 + j, sm + 8192);
    }
}

#define XB_TMO      128
#define XB_XCNT(j)  (256  + 64 * (j))
#define XB_XSUB(j)  (1280 + 64 * (j))
#define XB_XGEN(j)  (2304 + 64 * (j))
#define XB_TOP      3328
#define XB_TOPGEN   3392
#define XCD_BAR_WORDS 3456
#define XB_SPIN_CAP (1u << 18)
__device__ __forceinline__ unsigned xb_ld(unsigned* p)              { return __hip_atomic_load(p, __ATOMIC_RELAXED, __HIP_MEMORY_SCOPE_AGENT); }
__device__ __forceinline__ unsigned xb_add(unsigned* p, unsigned v) { return __hip_atomic_fetch_add(p, v, __ATOMIC_RELAXED, __HIP_MEMORY_SCOPE_AGENT); }
__device__ __forceinline__ unsigned xb_xcc_id() { return (unsigned)__builtin_amdgcn_s_getreg((3 << 11) | 20) & 0xFu; }
#define XB_SPIN(cond, bar) do { unsigned _sp = 0; while (cond) { __builtin_amdgcn_s_sleep(1); \
    if ((++_sp & 255u) == 0u) { if (xb_ld(&(bar)[XB_TMO])) break; if (_sp > XB_SPIN_CAP) { atomicAdd(&(bar)[XB_TMO], 1u); break; } } } } while (0)
struct XcdBarrier { unsigned* bar; unsigned x; volatile LAS unsigned* st; unsigned nloc, nx; };
__device__ __forceinline__ XcdBarrier xcd_barrier_post(unsigned* bar, volatile LAS unsigned* st) {
    XcdBarrier b; b.bar = bar; b.x = xb_xcc_id(); b.st = st; b.nloc = 0u; b.nx = 0u;
    if (threadIdx.x == 0) (void)xb_add(&bar[XB_XCNT(b.x)], 1u);
    return b;
}
__device__ __forceinline__ void xcd_barrier_complete(unsigned* bar, unsigned x, unsigned& nloc, unsigned& nx) {
    const unsigned G = gridDim.x * gridDim.y * gridDim.z;
    unsigned sum, cnt, mine, sp = 0u;
    for (;;) {
        sum = 0u; cnt = 0u; mine = 0u;
#pragma unroll
        for (unsigned j = 0; j < 16; ++j) { const unsigned c = xb_ld(&bar[XB_XCNT(j)]); sum += c; cnt += (c > 0u) ? 1u : 0u; mine = (j == x) ? c : mine; }
        if (sum == G) break;
        __builtin_amdgcn_s_sleep(1);
        if ((++sp & 255u) == 0u) { if (xb_ld(&bar[XB_TMO])) break; if (sp > XB_SPIN_CAP) { atomicAdd(&bar[XB_TMO], 1u); break; } }
    }
    nloc = mine > 0u ? mine : 1u; nx = cnt > 0u ? cnt : 1u;
}
__device__ __forceinline__ void xcd_barrier(XcdBarrier& b) {
    asm volatile("s_waitcnt vmcnt(0)" ::: "memory");
    __syncthreads();
    if (threadIdx.x == 0) {
        unsigned* bar = b.bar;
        __builtin_amdgcn_s_waitcnt(0);
        unsigned nloc = b.nloc, nx = b.nx;
        if (nloc == 0u) { xcd_barrier_complete(bar, b.x, nloc, nx); b.nloc = nloc; b.nx = nx; }
        const unsigned old = xb_add(&bar[XB_XSUB(b.x)], 1u);
        const unsigned gen = old / nloc;
        if (old + 1u == (gen + 1u) * nloc) {
            __builtin_amdgcn_fence(__ATOMIC_RELEASE, "agent");
            asm volatile("s_waitcnt vmcnt(0)" ::: "memory");
            const unsigned og = xb_add(&bar[XB_TOP], 1u);
            const unsigned tg = og / nx;
            if (og + 1u == (tg + 1u) * nx) xb_add(&bar[XB_TOPGEN], 1u);
            else XB_SPIN(xb_ld(&bar[XB_TOPGEN]) == tg, bar);
            __builtin_amdgcn_fence(__ATOMIC_ACQUIRE, "agent");
            xb_add(&bar[XB_XGEN(b.x)], 1u);
            asm volatile("s_waitcnt vmcnt(0)" ::: "memory");
        } else {
            XB_SPIN(xb_ld(&bar[XB_XGEN(b.x)]) == gen, bar);
            __builtin_amdgcn_fence(__ATOMIC_ACQUIRE, "agent");
            asm volatile("s_waitcnt vmcnt(0)" ::: "memory");
        }
    }
    __syncthreads();
}
constexpr size_t OFF_BAR = OFF_MISC + 768 * 1024;

__global__ void __launch_bounds__(256, 2) fwd_megakernel(Params p) {
    cg::grid_group grid = cg::this_grid();
    __shared__ __attribute__((aligned(16))) float sm[16384];
    unsigned char* ws = p.ws;
    if (ws == nullptr) grid.sync();
    XcdBarrier xb = xcd_barrier_post((unsigned*)(ws + OFF_BAR), nullptr);
    phase0(p, sm);
    xcd_barrier(xb);
    gemm1_phase(p, sm);
    gemm_phase_mfma((const bf16_t*)(ws + OFF_MEMB), 1024, (const bf16_t*)(ws + OFF_WXKV), 1024, 512, 2048, 1024, EpiBf16P{(bf16_t*)(ws + OFF_KVB), 2048}, sm);
    xcd_barrier(xb);
    ret_kv_mfma(p, sm);
    dil_mfma(p, sm);
    xcd_barrier(xb);
    ret_scan(p);
    if (blockIdx.x >= 256) deferred_prep(p, sm, blockIdx.x - 256, gridDim.x - 256);
    else if (gridDim.x <= 256) deferred_prep(p, sm, blockIdx.x, gridDim.x);
    xcd_barrier(xb);
    ret_out_mfma(p, sm);
    dil_merge(p);
    xcd_barrier(xb);
    gemm_phase_mfma((const bf16_t*)(ws + OFF_RB), 1024, (const bf16_t*)(ws + OFF_WOUT), 1024, T_, 1024, 1024, EpiV1{p.x, (bf16_t*)(ws + OFF_X1B), (float2*)(ws + OFF_ROPE)}, sm);
    xcd_barrier(xb);
    gemm_phase_mfma((const bf16_t*)(ws + OFF_X1B), 1024, (const bf16_t*)(ws + OFF_WXQ), 1024, T_, 1024, 1024,
                    EpiQ{(const float2*)(ws + OFF_ROPE), (const float*)(ws + OFF_G1), (bf16_t*)(ws + OFF_RB)}, sm);
    xcd_barrier(xb);
    xattn_mfma<1>(p, sm);
    xcd_barrier(xb);
    gemm_phase_mfma((const bf16_t*)(ws + OFF_OB), 1024, (const bf16_t*)(ws + OFF_WXO), 1024, T_, 1024, 1024, EpiXO{(const float2*)(ws + OFF_ROPE), (const bf16_t*)(ws + OFF_X1B), p.ln_mix_g, p.ln_mix_b, p.out}, sm);
    xcd_barrier(xb);
    route_tasks(p, p.out, sm);
    ln_pass<false>(p, p.out, p.ln_x_g, p.ln_x_b, nullptr, (bf16_t*)(ws + OFF_RB), sm);
    xcd_barrier(xb);
    moe_gu_naive(p, sm);
    xcd_barrier(xb);
    moe_down_naive(p, sm);
    xcd_barrier(xb);
    final_ln(p);
}

extern "C" void kernel_launch(void* const* d_in, const int* in_sizes, int n_in, void* d_out, int out_size, void* d_ws, size_t ws_size, hipStream_t stream) {
    static int grid_blocks = 0;
    if (!grid_blocks) {
        int dev = 0, cus = 0, per_cu = 0;
        (void)hipGetDevice(&dev);
        (void)hipDeviceGetAttribute(&cus, hipDeviceAttributeMultiprocessorCount, dev);
        (void)hipOccupancyMaxActiveBlocksPerMultiprocessor(&per_cu, fwd_megakernel, 256, 0);
        if (per_cu > 2) per_cu = 2;
        if (per_cu < 1) per_cu = 1;
        grid_blocks = cus * per_cu;
    }
    Params p{};
    p.x = (const float*)d_in[0]; p.mem = (const float*)d_in[1]; p.w_in = (const float*)d_in[2]; p.w_out = (const float*)d_in[3];
    p.ln_mix_g = (const float*)d_in[4]; p.ln_mix_b = (const float*)d_in[5]; p.w_xq = (const float*)d_in[6]; p.w_xkv = (const float*)d_in[7]; p.w_xo = (const float*)d_in[8];
    p.ln_x_g = (const float*)d_in[9]; p.ln_x_b = (const float*)d_in[10]; p.w_rg = (const float*)d_in[11]; p.w_re = (const float*)d_in[12];
    p.w_eg = (const float*)d_in[13]; p.w_eu = (const float*)d_in[14]; p.w_ed = (const float*)d_in[15]; p.ln_moe_g = (const float*)d_in[16]; p.ln_moe_b = (const float*)d_in[17];
    p.out = (float*)d_out; p.ws = (unsigned char*)d_ws;
    (void)hipMemsetAsync((unsigned char*)d_ws + OFF_BAR, 0, XCD_BAR_WORDS * 4, stream);
    void* args[] = {&p};
    hipError_t e = hipLaunchCooperativeKernel((void*)fwd_megakernel, dim3(grid_blocks), dim3(256), args, 0, stream);
    if (e != hipSuccess) fprintf(stderr, "cooperative launch failed: %s (grid %d)\n", hipGetErrorString(e), grid_blocks);
}
```
